# Optimizing an MI355X kernel written in HIP

```python
import jax, jax.numpy as jnp
from jax import lax
import numpy as np

D_MODEL = 1024
BATCH = 8
SEQ = 4096
DEPTH = 1

HEAD_DIM = 64
D_MIX = D_MODEL
NSA_WIDTH = D_MIX // 2
NSA_HEADS = NSA_WIDTH // HEAD_DIM
NSA_KV_HEADS = 2
NSA_GQA = NSA_HEADS // NSA_KV_HEADS
KV_WIDTH = NSA_KV_HEADS * HEAD_DIM
CMP_BLOCK = 32
CMP_STRIDE = 16
CMP_HIDDEN = 2 * HEAD_DIM
SEL_BLOCK = 64
SEL_TOPK = 16
WINDOW = 512
Q_BLOCK = 64
N_BRANCH = 3
RWKV_WIDTH = D_MIX - NSA_WIDTH
RWKV_HEADS = RWKV_WIDTH // HEAD_DIM
DECAY_LORA = 64
AAA_LORA = 64
GATE_LORA = 128
D_FF = 4 * D_MODEL
RMS_EPS = 1e-6
GN_EPS = HEAD_DIM * 1e-5
NEG_BIG = -1e30
FORCED_SCORE = 1e6
NSA_SIZES = (NSA_WIDTH,) + (KV_WIDTH,) * 6 + (NSA_HEADS * N_BRANCH,)
RWKV_SIZES = (RWKV_WIDTH,) * 3 + (DECAY_LORA, AAA_LORA, GATE_LORA)
NSA_COLS = sum(NSA_SIZES)
RWKV_COLS = sum(RWKV_SIZES)
D_IN_PROJ = NSA_COLS + RWKV_COLS

kernel_name = 'hybrid_nsa_rwkv7_layer'


def _split_points(sizes):
    return [int(v) for v in np.cumsum(sizes)[:-1]]


def rmsnorm(u, g):
    uf = u.astype(jnp.float32)
    y = uf * lax.rsqrt(jnp.mean(uf * uf, axis=-1, keepdims=True) + RMS_EPS)
    return (y * g.astype(jnp.float32)).astype(u.dtype)


def alibi_slopes(n):
    start = 2.0 ** (-8.0 / n)
    return (start ** np.arange(1, n + 1)).astype(np.float32)


def softmax_masked(s, valid):
    return jax.nn.softmax(jnp.where(valid, s, NEG_BIG), axis=-1) * valid


def compress_blocks(kv, pos, w1, w2):
    B, T = kv.shape[0], kv.shape[1]
    n_cmp = (T - CMP_BLOCK) // CMP_STRIDE + 1
    idx = np.arange(n_cmp)[:, None] * CMP_STRIDE + np.arange(CMP_BLOCK)[None, :]
    blocks = kv[:, idx] + pos[None, None, :, None, :]
    flat = blocks.transpose(0, 1, 3, 2, 4).reshape(B, n_cmp, NSA_KV_HEADS, CMP_BLOCK * HEAD_DIM)
    return jax.nn.gelu(flat @ w1) @ w2


def nsa_mixer(cols, slopes, gate_b, q_g, kc_g, ks_g, kw_g, ck_pos, ck_w1, ck_w2, cv_pos, cv_w1, cv_w2):
    B, T, _ = cols.shape
    H, KVH, G, dh = NSA_HEADS, NSA_KV_HEADS, NSA_GQA, HEAD_DIM
    q, kc, vc, ks, vs, kw, vw, gl = jnp.split(cols, _split_points(NSA_SIZES), axis=-1)
    q = rmsnorm(q.reshape(B, T, H, dh), q_g) * (dh ** -0.5)
    kc = rmsnorm(compress_blocks(kc.reshape(B, T, KVH, dh), ck_pos, ck_w1, ck_w2), kc_g)
    vc = compress_blocks(vc.reshape(B, T, KVH, dh), cv_pos, cv_w1, cv_w2)
    ks = rmsnorm(ks.reshape(B, T, KVH, dh), ks_g)
    vs = vs.reshape(B, T, KVH, dh)
    kw = rmsnorm(kw.reshape(B, T, KVH, dh), kw_g)
    vw = vw.reshape(B, T, KVH, dh)
    gates = jax.nn.sigmoid(gl + gate_b).reshape(B, T, KVH, G, N_BRANCH)

    n_cmp = kc.shape[1]
    n_sel = T // SEL_BLOCK
    top_k = min(SEL_TOPK, n_sel)
    cmp_end = jnp.arange(n_cmp) * CMP_STRIDE + (CMP_BLOCK - 1)
    ci = np.arange(n_cmp)[:, None] * CMP_STRIDE
    sj = np.arange(n_sel)[None, :] * SEL_BLOCK
    overlap = jnp.asarray(((ci <= sj + SEL_BLOCK - 1) & (ci + CMP_BLOCK - 1 >= sj)).astype(np.float32))
    ks_blk = ks.reshape(B, n_sel, SEL_BLOCK, KVH, dh).transpose(0, 3, 1, 2, 4)
    vs_blk = vs.reshape(B, n_sel, SEL_BLOCK, KVH, dh).transpose(0, 3, 1, 2, 4)
    kw_pad = jnp.pad(kw, ((0, 0), (WINDOW, 0), (0, 0), (0, 0)))
    vw_pad = jnp.pad(vw, ((0, 0), (WINDOW, 0), (0, 0), (0, 0)))
    m = slopes.reshape(KVH, G)
    b_idx = jnp.arange(B)[:, None, None, None]
    h_idx = jnp.arange(KVH)[None, :, None, None]
    sel_ids = jnp.arange(n_sel)
    blk_off = jnp.arange(SEL_BLOCK)
    win_off = jnp.arange(WINDOW + Q_BLOCK)

    def query_block(q0):
        t = q0 + jnp.arange(Q_BLOCK)
        qb = lax.dynamic_slice_in_dim(q, q0, Q_BLOCK, axis=1).reshape(B, Q_BLOCK, KVH, G, dh)
        gb = lax.dynamic_slice_in_dim(gates, q0, Q_BLOCK, axis=1)
        d_c = (t[:, None] - cmp_end[None, :]).astype(jnp.float32)
        s_c = jnp.einsum('bqhgd,bnhd->bhgqn', qb, kc).astype(jnp.float32) - m[:, :, None, None] * d_c
        p_c = softmax_masked(s_c, d_c >= 0)
        o_c = jnp.einsum('bhgqn,bnhd->bqhgd', p_c.astype(vc.dtype), vc)
        imp = jnp.einsum('bhgqn,nj->bhqj', p_c, overlap)
        cur = (t // SEL_BLOCK)[:, None]
        forced = (sel_ids == 0) | (sel_ids == cur) | (sel_ids == cur - 1)
        imp = jnp.where(forced, FORCED_SCORE, jnp.where(sel_ids > cur, NEG_BIG, imp))
        _, sel = lax.top_k(imp, top_k)
        k_g = ks_blk[b_idx, h_idx, sel]
        v_g = vs_blk[b_idx, h_idx, sel]
        d_s = (t[None, None, :, None, None] - (sel[..., None] * SEL_BLOCK + blk_off)).astype(jnp.float32)
        s_s = jnp.einsum('bqhgd,bhqksd->bhgqks', qb, k_g).astype(jnp.float32) - m[:, :, None, None, None] * d_s[:, :, None]
        valid_s = (d_s >= 0)[:, :, None].reshape(B, KVH, 1, Q_BLOCK, top_k * SEL_BLOCK)
        p_s = softmax_masked(s_s.reshape(B, KVH, G, Q_BLOCK, top_k * SEL_BLOCK), valid_s)
        p_s = p_s.reshape(B, KVH, G, Q_BLOCK, top_k, SEL_BLOCK)
        o_s = jnp.einsum('bhgqks,bhqksd->bqhgd', p_s.astype(v_g.dtype), v_g)
        kwb = lax.dynamic_slice_in_dim(kw_pad, q0, WINDOW + Q_BLOCK, axis=1)
        vwb = lax.dynamic_slice_in_dim(vw_pad, q0, WINDOW + Q_BLOCK, axis=1)
        s_pos = q0 - WINDOW + win_off
        d_w = t[:, None] - s_pos[None, :]
        valid_w = (d_w >= 0) & (d_w < WINDOW) & (s_pos[None, :] >= 0)
        s_w = jnp.einsum('bqhgd,bshd->bhgqs', qb, kwb).astype(jnp.float32) - m[:, :, None, None] * d_w.astype(jnp.float32)
        p_w = softmax_masked(s_w, valid_w)
        o_w = jnp.einsum('bhgqs,bshd->bqhgd', p_w.astype(vwb.dtype), vwb)
        o = gb[..., 0:1] * o_c + gb[..., 1:2] * o_s + gb[..., 2:3] * o_w
        return o.reshape(B, Q_BLOCK, H * dh)

    out = lax.map(query_block, jnp.arange(T // Q_BLOCK) * Q_BLOCK)
    return out.transpose(1, 0, 2, 3).reshape(B, T, H * dh)


def wkv7_scan(r, w, k, v, a, b):
    B, T, H, N = r.shape

    def step(state, inp):
        r_t, w_t, k_t, v_t, a_t, b_t = inp
        sa = jnp.einsum('bhvk,bhk->bhv', state, a_t)
        state = state * w_t[:, :, None, :] + sa[..., None] * b_t[:, :, None, :] + v_t[..., None] * k_t[:, :, None, :]
        return state, jnp.einsum('bhvk,bhk->bhv', state, r_t)

    xs = tuple(jnp.swapaxes(u, 0, 1) for u in (r, w, k, v, a, b))
    _, ys = lax.scan(step, jnp.zeros((B, H, N, N), jnp.float32), xs)
    return jnp.swapaxes(ys, 0, 1)


def rwkv7_mixer(cols, mu, w0, w2, a0, a2, g2, k_k, k_a, r_k, lnx_w, lnx_b):
    B, T, _ = cols.shape
    H, N = RWKV_HEADS, HEAD_DIM
    prev = jnp.pad(cols, ((0, 0), (1, 0), (0, 0)))[:, :-1]
    z = cols + (prev - cols) * mu
    r, k, v, xw, xa, xg = jnp.split(z, _split_points(RWKV_SIZES), axis=-1)
    w_log = -jax.nn.softplus(-(w0 + jnp.tanh(xw) @ w2)) - 0.5
    decay = jnp.exp(-jnp.exp(w_log.astype(jnp.float32)))
    a = jax.nn.sigmoid(a0 + xa @ a2)
    g = jax.nn.sigmoid(xg) @ g2
    heads = lambda u: u.reshape(B, T, H, N).astype(jnp.float32)
    kk = heads(k * k_k)
    kk = kk * lax.rsqrt(jnp.maximum(jnp.sum(kk * kk, axis=-1, keepdims=True), 1e-24))
    k = k * (1 + (a - 1) * k_a)
    rh, kh, vh, ah = heads(r), heads(k), heads(v), heads(a)
    y = wkv7_scan(rh, decay.reshape(B, T, H, N), kh, vh, -kk, kk * ah)
    mean = jnp.mean(y, axis=-1, keepdims=True)
    var = jnp.mean(jnp.square(y - mean), axis=-1, keepdims=True)
    y = ((y - mean) * lax.rsqrt(var + GN_EPS)).reshape(B, T, RWKV_WIDTH) * lnx_w + lnx_b
    bonus = jnp.sum(rh * kh * r_k, axis=-1, keepdims=True) * vh
    y = y + bonus.reshape(B, T, RWKV_WIDTH)
    return (y * g).astype(cols.dtype)


def setup_inputs(seed: int = 0) -> dict:
    key = jax.random.key(seed)
    ks = jax.random.split(key, 32)
    L, dh = DEPTH, HEAD_DIM
    nrm = lambda k, shape, scale: jax.random.normal(k, shape, jnp.float32) * scale
    gain = lambda k, shape: 1.0 + 0.02 * jax.random.normal(k, shape, jnp.float32)
    return {
        'x': jax.random.normal(ks[0], (BATCH, SEQ, D_MODEL), jnp.float32),
        'ln_mix_g': gain(ks[1], (L, D_MODEL)),
        'w_in': nrm(ks[2], (L, D_MODEL, D_IN_PROJ), D_MODEL ** -0.5),
        'nsa_gate_b': nrm(ks[3], (L, NSA_HEADS * N_BRANCH), 0.1),
        'q_norm_g': gain(ks[4], (L, dh)),
        'kc_norm_g': gain(ks[5], (L, dh)),
        'ks_norm_g': gain(ks[6], (L, dh)),
        'kw_norm_g': gain(ks[7], (L, dh)),
        'cmp_k_pos': nrm(ks[8], (L, CMP_BLOCK, dh), 0.1),
        'cmp_k_w1': nrm(ks[9], (L, CMP_BLOCK * dh, CMP_HIDDEN), (CMP_BLOCK * dh) ** -0.5),
        'cmp_k_w2': nrm(ks[10], (L, CMP_HIDDEN, dh), CMP_HIDDEN ** -0.5),
        'cmp_v_pos': nrm(ks[11], (L, CMP_BLOCK, dh), 0.1),
        'cmp_v_w1': nrm(ks[12], (L, CMP_BLOCK * dh, CMP_HIDDEN), (CMP_BLOCK * dh) ** -0.5),
        'cmp_v_w2': nrm(ks[13], (L, CMP_HIDDEN, dh), CMP_HIDDEN ** -0.5),
        'rwkv_mu': jax.random.uniform(ks[14], (L, RWKV_COLS), jnp.float32),
        'rwkv_w0': jax.random.uniform(ks[15], (L, RWKV_WIDTH), jnp.float32, -4.0, 1.0),
        'rwkv_w2': nrm(ks[16], (L, DECAY_LORA, RWKV_WIDTH), 0.1),
        'rwkv_a0': nrm(ks[17], (L, RWKV_WIDTH), 0.1),
        'rwkv_a2': nrm(ks[18], (L, AAA_LORA, RWKV_WIDTH), 0.1),
        'rwkv_g2': nrm(ks[19], (L, GATE_LORA, RWKV_WIDTH), GATE_LORA ** -0.5),
        'rwkv_k_k': 0.85 + 0.02 * jax.random.normal(ks[20], (L, RWKV_WIDTH), jnp.float32),
        'rwkv_k_a': gain(ks[21], (L, RWKV_WIDTH)),
        'rwkv_r_k': nrm(ks[22], (L, RWKV_HEADS, dh), 0.1),
        'rwkv_lnx_w': gain(ks[23], (L, RWKV_WIDTH)),
        'rwkv_lnx_b': nrm(ks[24], (L, RWKV_WIDTH), 0.02),
        'w_out': nrm(ks[25], (L, D_MIX, D_MODEL), D_MIX ** -0.5),
        'ln_ffn_g': gain(ks[26], (L, D_MODEL)),
        'w_ff1': nrm(ks[27], (L, D_MODEL, D_FF), D_MODEL ** -0.5),
        'w_ff2': nrm(ks[28], (L, D_FF, D_MODEL), D_FF ** -0.5),
    }


def reference(x, ln_mix_g, w_in, nsa_gate_b, q_norm_g, kc_norm_g, ks_norm_g, kw_norm_g,
              cmp_k_pos, cmp_k_w1, cmp_k_w2, cmp_v_pos, cmp_v_w1, cmp_v_w2,
              rwkv_mu, rwkv_w0, rwkv_w2, rwkv_a0, rwkv_a2, rwkv_g2, rwkv_k_k, rwkv_k_a, rwkv_r_k,
              rwkv_lnx_w, rwkv_lnx_b, w_out, ln_ffn_g, w_ff1, w_ff2):
    slopes = jnp.asarray(alibi_slopes(NSA_HEADS))
    for l in range(DEPTH):
        proj = rmsnorm(x, ln_mix_g[l]) @ w_in[l]
        y_nsa = nsa_mixer(proj[..., :NSA_COLS], slopes, nsa_gate_b[l], q_norm_g[l], kc_norm_g[l],
                          ks_norm_g[l], kw_norm_g[l], cmp_k_pos[l], cmp_k_w1[l], cmp_k_w2[l],
                          cmp_v_pos[l], cmp_v_w1[l], cmp_v_w2[l])
        y_rwkv = rwkv7_mixer(proj[..., NSA_COLS:], rwkv_mu[l], rwkv_w0[l], rwkv_w2[l], rwkv_a0[l],
                             rwkv_a2[l], rwkv_g2[l], rwkv_k_k[l], rwkv_k_a[l], rwkv_r_k[l],
                             rwkv_lnx_w[l], rwkv_lnx_b[l])
        x = x + jnp.concatenate([y_nsa, y_rwkv], axis=-1) @ w_out[l]
        hidden = jnp.square(jax.nn.relu(rmsnorm(x, ln_ffn_g[l]) @ w_ff1[l]))
        x = x + hidden @ w_ff2[l]
    return x
```

```cpp
#include <hip/hip_runtime.h>
#include <hip/hip_cooperative_groups.h>
#include <stdint.h>
#include <stdio.h>
namespace cg = cooperative_groups;

typedef __attribute__((ext_vector_type(8))) short bf16x8;
typedef __attribute__((ext_vector_type(4))) short s16x4;
typedef __attribute__((ext_vector_type(16))) float f32x16;
typedef __attribute__((ext_vector_type(2))) float f32x2;
typedef __attribute__((ext_vector_type(2))) _Float16 bfx2;
typedef __attribute__((ext_vector_type(8))) _Float16 h16x8;
typedef unsigned short u16;
#define DI __device__ __forceinline__
#define MFMA(a, b, c) __builtin_amdgcn_mfma_f32_32x32x16_f16(__builtin_bit_cast(h16x8, (a)), __builtin_bit_cast(h16x8, (b)), (c), 0, 0, 0)

constexpr int Bz = 8, T = 4096, M = Bz * T, NP = 3200;
constexpr int KC_OFF = 512, VC_OFF = 640, KS_OFF = 768, VS_OFF = 896, KW_OFF = 1024, VW_OFF = 1152,
              R_OFF = 1280, K_OFF = 1792, V_OFF = 2304, XW_OFF = 2816, XA_OFF = 2880, XG_OFF = 2944, GL_OFF = 3072;
constexpr int NCMP_ROWS = 8 * 255 * 2;

constexpr size_t OFF_WTIN = 0;
constexpr size_t OFF_WTOUT = OFF_WTIN + (size_t)3200 * 1024 * 2;
constexpr size_t OFF_WTFF1 = OFF_WTOUT + (size_t)1024 * 1024 * 2;
constexpr size_t OFF_WTFF2 = OFF_WTFF1 + (size_t)4096 * 1024 * 2;
constexpr size_t OFF_CW1T = OFF_WTFF2 + (size_t)4096 * 1024 * 2;
constexpr size_t OFF_W2T = OFF_CW1T + (size_t)2 * 128 * 2048 * 2;
constexpr size_t OFF_A2T = OFF_W2T + (size_t)512 * 64 * 2;
constexpr size_t OFF_G2T = OFF_A2T + (size_t)512 * 64 * 2;
constexpr size_t OFF_PBIAS = OFF_G2T + (size_t)512 * 128 * 2;
constexpr size_t OFF_CTR = OFF_PBIAS + 1024;
constexpr size_t OFF_KCN = OFF_CTR + 4096;
constexpr size_t OFF_VCT = OFF_KCN + (size_t)8 * 2 * 256 * 64 * 2;
constexpr size_t OFF_VST = OFF_VCT + (size_t)8 * 2 * 256 * 64 * 2;
constexpr size_t OFF_VWT = OFF_VST + (size_t)8 * 2 * 64 * 4096 * 2;
constexpr size_t OFF_BUFA = OFF_VWT + (size_t)8 * 2 * 64 * 4096 * 2;
constexpr size_t OFF_PROJ = OFF_BUFA + (size_t)M * 1024 * 2;
constexpr size_t OFF_AA = OFF_PROJ + (size_t)M * NP * 2;
constexpr size_t OFF_MIX = OFF_AA + (size_t)M * 512 * 4;
constexpr size_t OFF_G = OFF_MIX + (size_t)M * 1024 * 2;
constexpr size_t OFF_T0 = OFF_G + (size_t)M * 512 * 2;
constexpr size_t OFF_PBP = OFF_T0 + 65536;
constexpr size_t OFF_BON = OFF_PBP + 65536;

struct Params {
  const float *x, *ln_mix_g, *w_in, *gate_b, *q_g, *kc_g, *ks_g, *kw_g;
  const float *ck_pos, *ck_w1, *ck_w2, *cv_pos, *cv_w1, *cv_w2;
  const float *mu, *w0, *w2, *a0, *a2, *g2, *k_k, *k_a, *r_k, *lnx_w, *lnx_b;
  const float *w_out, *ln_ffn_g, *w_ff1, *w_ff2;
  float* out;
  char* ws;
};

DI int launder(int x) { asm volatile("" : "+v"(x)); return x; }
DI float bf2f(u16 h) { return (float)__builtin_bit_cast(_Float16, h); }
DI unsigned pack2(float a, float b) { f32x2 v = {a, b}; bfx2 r = __builtin_convertvector(v, bfx2); return __builtin_bit_cast(unsigned, r); }
DI u16 f2bf(float a) { return (u16)(pack2(a, 0.f) & 0xffffu); }
DI float lo_bf(unsigned u) { bfx2 h = __builtin_bit_cast(bfx2, u); return (float)h[0]; }
DI float hi_bf(unsigned u) { bfx2 h = __builtin_bit_cast(bfx2, u); return (float)h[1]; }
DI float sigmoidf_(float x) { return 1.f / (1.f + __expf(-x)); }
DI float wave_sum(float v) {
  v += __shfl_xor(v, 32); v += __shfl_xor(v, 16); v += __shfl_xor(v, 8);
  v += __shfl_xor(v, 4); v += __shfl_xor(v, 2); v += __shfl_xor(v, 1);
  return v;
}
template <int CTRL> DI float dpp_f(float v) {
  return __builtin_bit_cast(float, __builtin_amdgcn_update_dpp(0, __builtin_bit_cast(int, v), CTRL, 0xF, 0xF, false));
}
DI float oct_sum(float v) { v += dpp_f<0xB1>(v); v += dpp_f<0x4E>(v); v += dpp_f<0x141>(v); return v; }
DI float quad_sum(float v) { v += dpp_f<0xB1>(v); v += dpp_f<0x4E>(v); return v; }
DI float row16_sum(float v) { v += dpp_f<0x128>(v); v += dpp_f<0x124>(v); v += dpp_f<0x122>(v); v += dpp_f<0x121>(v); return v; }

constexpr size_t PROJ_B = (size_t)T * NP * 2, AA_B = (size_t)T * 512 * 4, SLAB = PROJ_B + AA_B;
static_assert((size_t)T * 4096 * 2 <= SLAB, "hidden must fit its batch slab");
DI size_t prow(size_t m) { return m * NP + (m >> 12) * (AA_B / 2); }
DI float* aaptr(char* ws, size_t m) { return (float*)(ws + OFF_PROJ + (m >> 12) * SLAB + PROJ_B) + (m & 4095) * 512; }
DI size_t hid_off(int m, int c) { const int ml = m & 4095; return (size_t)(m >> 12) * (SLAB / 2) + ((size_t)((ml >> 8) * 128 + (c >> 5)) << 13) + (size_t)((ml & 255) * 32 + (c & 31)); }
DI int map_win(int nd) { return nd < 1280 ? nd : (nd < 3072 ? nd + 24 : (nd < 3096 ? nd - 3072 + 1280 : -1)); }

DI void transpose_tile(const float* __restrict__ src, int ldsrc, u16* __restrict__ dst, int Kd, int k0, int n0, bool mapped, char* smem) {
  float* s = (float*)smem;
  const int tid = threadIdx.x;
  __syncthreads();
  const int nn = tid & 63;
  const int nd = n0 + nn;
  const int sc = mapped ? map_win(nd) : nd;
#pragma unroll 4
  for (int i = 0; i < 16; ++i) {
    int k = (tid >> 6) + 4 * i;
    float v = (sc >= 0) ? src[(size_t)(k0 + k) * ldsrc + sc] : 0.f;
    s[k * 65 + nn] = v;
  }
  __syncthreads();
  const int n = tid >> 2, kc = (tid & 3) * 16;
  unsigned pk[8];
#pragma unroll
  for (int e = 0; e < 8; ++e) pk[e] = pack2(s[(kc + 2 * e) * 65 + n], s[(kc + 2 * e + 1) * 65 + n]);
  uint4* d = (uint4*)(dst + (size_t)(n0 + n) * Kd + k0 + kc);
  d[0] = make_uint4(pk[0], pk[1], pk[2], pk[3]);
  d[1] = make_uint4(pk[4], pk[5], pk[6], pk[7]);
  __syncthreads();
}

DI void rmsnorm_rows(const float* __restrict__ src, const float* __restrict__ g, u16* __restrict__ dst, int item) {
  const int lane = threadIdx.x & 63, w = threadIdx.x >> 6;
  const size_t row0 = (size_t)item * 8 + w, row1 = row0 + 4;
  const float4* s0 = (const float4*)(src + row0 * 1024);
  const float4* s1 = (const float4*)(src + row1 * 1024);
  float4 v0[4], v1[4];
#pragma unroll
  for (int i = 0; i < 4; ++i) { v0[i] = s0[lane + 64 * i]; v1[i] = s1[lane + 64 * i]; }
  float ss0 = 0.f, ss1 = 0.f;
#pragma unroll
  for (int i = 0; i < 4; ++i) {
    ss0 += v0[i].x * v0[i].x + v0[i].y * v0[i].y + v0[i].z * v0[i].z + v0[i].w * v0[i].w;
    ss1 += v1[i].x * v1[i].x + v1[i].y * v1[i].y + v1[i].z * v1[i].z + v1[i].w * v1[i].w;
  }
  ss0 = wave_sum(ss0); ss1 = wave_sum(ss1);
  const float sc0 = rsqrtf(ss0 * (1.f / 1024.f) + 1e-6f), sc1 = rsqrtf(ss1 * (1.f / 1024.f) + 1e-6f);
  const float4* g4 = (const float4*)g;
#pragma unroll
  for (int i = 0; i < 4; ++i) {
    const float4 gg = g4[lane + 64 * i];
    *(uint2*)(dst + row0 * 1024 + (lane + 64 * i) * 4) = make_uint2(pack2(v0[i].x * sc0 * gg.x, v0[i].y * sc0 * gg.y), pack2(v0[i].z * sc0 * gg.z, v0[i].w * sc0 * gg.w));
    *(uint2*)(dst + row1 * 1024 + (lane + 64 * i) * 4) = make_uint2(pack2(v1[i].x * sc1 * gg.x, v1[i].y * sc1 * gg.y), pack2(v1[i].z * sc1 * gg.z, v1[i].w * sc1 * gg.w));
  }
}

enum { G_INPROJ = 0, G_CMP, G_RWG, G_RWW, G_RWA, G_OUT, G_FF1, G_FF2 };

template <int MODE> DI constexpr int gemm_kt() {
  return MODE == G_INPROJ ? 16 : MODE == G_CMP ? 32 : MODE == G_RWG ? 2 : MODE == G_RWW ? 1 : MODE == G_RWA ? 1 : MODE == G_OUT ? 16 : MODE == G_FF1 ? 16 : 64;
}

template <int MODE> DI uint4 load_a(const Params& p, int tm, int kv, int row, int kt, int c) {
  const u16* proj = (const u16*)(p.ws + OFF_PROJ);
  if constexpr (MODE == G_INPROJ || MODE == G_FF1) {
    const u16* A = (const u16*)(p.ws + OFF_BUFA);
    return *(const uint4*)(A + (size_t)(tm * 128 + row) * 1024 + kt * 64 + c * 8);
  } else if constexpr (MODE == G_OUT) {
    const u16* A = (const u16*)(p.ws + OFF_MIX);
    return *(const uint4*)(A + (size_t)(tm * 128 + row) * 1024 + kt * 64 + c * 8);
  } else if constexpr (MODE == G_FF2) {
    const u16* A = (const u16*)(p.ws + OFF_PROJ);
    return *(const uint4*)(A + hid_off(tm * 128 + row, kt * 64 + c * 8));
  } else if constexpr (MODE == G_CMP) {
    const int b = tm >> 2; int rem = (tm & 3) * 128 + row; rem = rem < 510 ? rem : 509;
    const int i = rem >> 1, h = rem & 1;
    return *(const uint4*)(proj + prow((size_t)(b * T + 16 * i + kt)) + (kv ? VC_OFF : KC_OFF) + h * 64 + c * 8);
  } else {
    constexpr int OFFX = MODE == G_RWG ? XG_OFF : MODE == G_RWW ? XW_OFF : XA_OFF;
    const int m = tm * 128 + row;
    const int col = OFFX + kt * 64 + c * 8;
    const uint4 cur = *(const uint4*)(proj + prow(m) + col);
    uint4 prv = make_uint4(0, 0, 0, 0);
    if ((m & (T - 1)) != 0) prv = *(const uint4*)(proj + prow(m - 1) + col);
    const float4* mu4 = (const float4*)(p.mu + (col - 1280));
    const float4 m0 = mu4[0], m1 = mu4[1];
    const unsigned cu[4] = {cur.x, cur.y, cur.z, cur.w}, pu[4] = {prv.x, prv.y, prv.z, prv.w};
    const float mm[8] = {m0.x, m0.y, m0.z, m0.w, m1.x, m1.y, m1.z, m1.w};
    unsigned o[4];
#pragma unroll
    for (int e = 0; e < 4; ++e) {
      float c0 = lo_bf(cu[e]), c1 = hi_bf(cu[e]), p0 = lo_bf(pu[e]), p1 = hi_bf(pu[e]);
      float z0 = c0 + (p0 - c0) * mm[2 * e], z1 = c1 + (p1 - c1) * mm[2 * e + 1];
      if constexpr (MODE == G_RWG) { z0 = sigmoidf_(z0); z1 = sigmoidf_(z1); }
      if constexpr (MODE == G_RWW) { z0 = tanhf(z0); z1 = tanhf(z1); }
      o[e] = pack2(z0, z1);
    }
    return make_uint4(o[0], o[1], o[2], o[3]);
  }
}

template <int MODE> DI uint4 load_b(const Params& p, int tn, int kv, int row, int kt, int c) {
  if constexpr (MODE == G_INPROJ) return *(const uint4*)((const u16*)(p.ws + OFF_WTIN) + (size_t)(tn * 128 + row) * 1024 + kt * 64 + c * 8);
  else if constexpr (MODE == G_OUT) return *(const uint4*)((const u16*)(p.ws + OFF_WTOUT) + (size_t)(tn * 128 + row) * 1024 + kt * 64 + c * 8);
  else if constexpr (MODE == G_FF1) return *(const uint4*)((const u16*)(p.ws + OFF_WTFF1) + (size_t)(tn * 128 + row) * 1024 + kt * 64 + c * 8);
  else if constexpr (MODE == G_FF2) return *(const uint4*)((const u16*)(p.ws + OFF_WTFF2) + (size_t)(tn * 128 + row) * 4096 + kt * 64 + c * 8);
  else if constexpr (MODE == G_CMP) return *(const uint4*)((const u16*)(p.ws + OFF_CW1T) + (size_t)(kv * 128 + row) * 2048 + kt * 64 + c * 8);
  else if constexpr (MODE == G_RWG) return *(const uint4*)((const u16*)(p.ws + OFF_G2T) + (size_t)(tn * 128 + row) * 128 + kt * 64 + c * 8);
  else if constexpr (MODE == G_RWW) return *(const uint4*)((const u16*)(p.ws + OFF_W2T) + (size_t)(tn * 128 + row) * 64 + c * 8);
  else return *(const uint4*)((const u16*)(p.ws + OFF_A2T) + (size_t)(tn * 128 + row) * 64 + c * 8);
}

DI float gelu_tanh(float x) {
  const float u = 0.7978845608028654f * (x + 0.044715f * x * x * x);
  return 0.5f * x * (1.f + tanhf(u));
}

template <int MODE, bool BIG = false> DI void gemm_tile(const Params& p, int tm, int tn, int kv, char* smem) {
  constexpr int KT = gemm_kt<MODE>();
  constexpr int RB = BIG ? 256 : 128;
  constexpr int MT = BIG ? 4 : 2;
  const int tid = launder(threadIdx.x), lane = tid & 63, w = tid >> 6;
  const int r = lane & 31, hf = lane >> 5;
  const int wm = w >> 1, wn = w & 1;
  char* As = smem;
  char* Bs = smem + 128 * 144;
  float* Cs = (float*)smem;
  const int tma = BIG ? tm * 2 : tm;

  f32x16 acc[MT][2];
#pragma unroll
  for (int i = 0; i < MT; ++i)
#pragma unroll
    for (int j = 0; j < 2; ++j)
#pragma unroll
      for (int e = 0; e < 16; ++e) acc[i][j][e] = 0.f;

  if constexpr (!BIG) {
    uint4 ra[4], rb[4];
#pragma unroll
    for (int i = 0; i < 4; ++i) { const int id = tid + 256 * i; ra[i] = load_a<MODE>(p, tma, kv, id >> 3, 0, id & 7); rb[i] = load_b<MODE>(p, tn, kv, id >> 3, 0, id & 7); }
    for (int kt = 0; kt < KT; ++kt) {
      __syncthreads();
#pragma unroll
      for (int i = 0; i < 4; ++i) {
        const int id = tid + 256 * i;
        *(uint4*)(As + (id >> 3) * 144 + (id & 7) * 16) = ra[i];
        *(uint4*)(Bs + (id >> 3) * 144 + (id & 7) * 16) = rb[i];
      }
      __syncthreads();
      if (kt + 1 < KT) {
#pragma unroll
        for (int i = 0; i < 4; ++i) { const int id = tid + 256 * i; ra[i] = load_a<MODE>(p, tma, kv, id >> 3, kt + 1, id & 7); rb[i] = load_b<MODE>(p, tn, kv, id >> 3, kt + 1, id & 7); }
      }
#pragma unroll
      for (int s = 0; s < 4; ++s) {
        bf16x8 af[2], bfr[2];
#pragma unroll
        for (int i = 0; i < 2; ++i) af[i] = *(const bf16x8*)(As + (wm * 64 + i * 32 + r) * 144 + s * 32 + hf * 16);
#pragma unroll
        for (int j = 0; j < 2; ++j) bfr[j] = *(const bf16x8*)(Bs + (wn * 64 + j * 32 + r) * 144 + s * 32 + hf * 16);
#pragma unroll
        for (int i = 0; i < 2; ++i)
#pragma unroll
          for (int j = 0; j < 2; ++j) acc[i][j] = MFMA(af[i], bfr[j], acc[i][j]);
      }
    }
  } else {
    char* Bs2 = smem + 256 * 80;
    uint4 ra[4], rb[2];
#pragma unroll
    for (int i = 0; i < 4; ++i) { const int id = tid + 256 * i; ra[i] = load_a<MODE>(p, tma, kv, id >> 2, 0, id & 3); }
#pragma unroll
    for (int i = 0; i < 2; ++i) { const int id = tid + 256 * i; rb[i] = load_b<MODE>(p, tn, kv, id >> 2, 0, id & 3); }
    for (int kt = 0; kt < 2 * KT; ++kt) {
      __syncthreads();
#pragma unroll
      for (int i = 0; i < 4; ++i) { const int id = tid + 256 * i; *(uint4*)(As + (id >> 2) * 80 + (id & 3) * 16) = ra[i]; }
#pragma unroll
      for (int i = 0; i < 2; ++i) { const int id = tid + 256 * i; *(uint4*)(Bs2 + (id >> 2) * 80 + (id & 3) * 16) = rb[i]; }
      __syncthreads();
      if (kt + 1 < 2 * KT) {
        const int k1 = kt + 1;
#pragma unroll
        for (int i = 0; i < 4; ++i) { const int id = tid + 256 * i; ra[i] = load_a<MODE>(p, tma, kv, id >> 2, k1 >> 1, ((k1 & 1) << 2) | (id & 3)); }
#pragma unroll
        for (int i = 0; i < 2; ++i) { const int id = tid + 256 * i; rb[i] = load_b<MODE>(p, tn, kv, id >> 2, k1 >> 1, ((k1 & 1) << 2) | (id & 3)); }
      }
      {
        bf16x8 af[2][4], bfr[2][2];
#pragma unroll
        for (int s = 0; s < 2; ++s) {
#pragma unroll
          for (int i = 0; i < 4; ++i) af[s][i] = *(const bf16x8*)(As + (wm * 128 + i * 32 + r) * 80 + s * 32 + hf * 16);
#pragma unroll
          for (int j = 0; j < 2; ++j) bfr[s][j] = *(const bf16x8*)(Bs2 + (wn * 64 + j * 32 + r) * 80 + s * 32 + hf * 16);
        }
        __builtin_amdgcn_s_setprio(1);
#pragma unroll
        for (int s = 0; s < 2; ++s)
#pragma unroll
          for (int i = 0; i < 4; ++i)
#pragma unroll
            for (int j = 0; j < 2; ++j) acc[i][j] = MFMA(af[s][i], bfr[s][j], acc[i][j]);
        __builtin_amdgcn_s_setprio(0);
      }
    }
  }
#pragma unroll 1
  for (int hh = 0; hh < (BIG ? 2 : 1); ++hh) {
  __syncthreads();
  if (!BIG || wm == hh) {
#pragma unroll
    for (int i = 0; i < MT; ++i)
#pragma unroll
      for (int j = 0; j < 2; ++j)
#pragma unroll
        for (int e = 0; e < 16; ++e) {
          const int row = (BIG ? 0 : wm * 64) + i * 32 + 8 * (e >> 2) + 4 * hf + (e & 3);
          const int col = wn * 64 + j * 32 + r;
          Cs[row * 132 + col] = acc[i][j][e];
        }
  }
  __syncthreads();

  const int row = tid >> 1, half = tid & 1;
  float* crow = Cs + row * 132 + half * 64;
  const float4* crow4 = (const float4*)crow;
  const int m = tm * RB + hh * 128 + row;
  const int col0 = tn * 128 + half * 64;

  if constexpr (MODE == G_INPROJ) {
    u16* proj = (u16*)(p.ws + OFF_PROJ);
    const int region = col0 >> 6;
    const float* g = nullptr; float extra = 1.f;
    if (region < 8) { g = p.q_g; extra = 0.125f; }
    else if (region == 12 || region == 13) g = p.ks_g;
    else if (region == 16 || region == 17) g = p.kw_g;
    float sc = 1.f;
    if (g) {
      float ss = 0.f;
#pragma unroll
      for (int c4 = 0; c4 < 16; ++c4) { float4 v = crow4[c4]; ss += v.x * v.x + v.y * v.y + v.z * v.z + v.w * v.w; }
      sc = rsqrtf(ss * (1.f / 64.f) + 1e-6f) * extra;
    }
#pragma unroll
    for (int c8 = 0; c8 < 8; ++c8) {
      float4 v0 = crow4[2 * c8], v1 = crow4[2 * c8 + 1];
      float v[8] = {v0.x, v0.y, v0.z, v0.w, v1.x, v1.y, v1.z, v1.w};
      if (g) {
#pragma unroll
        for (int e = 0; e < 8; ++e) v[e] = v[e] * sc * g[c8 * 8 + e];
      } else if (region == 48) {
#pragma unroll
        for (int e = 0; e < 8; ++e) { int c = c8 * 8 + e; v[e] = c < 24 ? sigmoidf_(v[e] + p.gate_b[c]) : 0.f; }
      }
      *(uint4*)(proj + prow(m) + col0 + c8 * 8) = make_uint4(pack2(v[0], v[1]), pack2(v[2], v[3]), pack2(v[4], v[5]), pack2(v[6], v[7]));
    }
  } else if constexpr (MODE == G_OUT) {
    const float4* x4 = (const float4*)(p.x + (size_t)m * 1024 + col0);
    float4* o4 = (float4*)(p.out + (size_t)m * 1024 + col0);
#pragma unroll
    for (int c4 = 0; c4 < 16; ++c4) { float4 v = crow4[c4], xx = x4[c4]; o4[c4] = make_float4(v.x + xx.x, v.y + xx.y, v.z + xx.z, v.w + xx.w); }
  } else if constexpr (MODE == G_FF2) {
    float4* o4 = (float4*)(p.out + (size_t)m * 1024 + col0);
#pragma unroll
    for (int c4 = 0; c4 < 16; ++c4) { float4 v = crow4[c4], xx = o4[c4]; o4[c4] = make_float4(v.x + xx.x, v.y + xx.y, v.z + xx.z, v.w + xx.w); }
  } else if constexpr (MODE == G_FF1) {
    u16* hid = (u16*)(p.ws + OFF_PROJ);
#pragma unroll
    for (int c8 = 0; c8 < 8; ++c8) {
      float4 v0 = crow4[2 * c8], v1 = crow4[2 * c8 + 1];
      float v[8] = {v0.x, v0.y, v0.z, v0.w, v1.x, v1.y, v1.z, v1.w};
#pragma unroll
      for (int e = 0; e < 8; ++e) { float t = fmaxf(v[e], 0.f); v[e] = t * t; }
      *(uint4*)(hid + hid_off(m, col0 + c8 * 8)) = make_uint4(pack2(v[0], v[1]), pack2(v[2], v[3]), pack2(v[4], v[5]), pack2(v[6], v[7]));
    }
  } else if constexpr (MODE == G_RWG) {
    u16* gb = (u16*)(p.ws + OFF_G);
#pragma unroll
    for (int c8 = 0; c8 < 8; ++c8) {
      float4 v0 = crow4[2 * c8], v1 = crow4[2 * c8 + 1];
      *(uint4*)(gb + (size_t)m * 512 + col0 + c8 * 8) = make_uint4(pack2(v0.x, v0.y), pack2(v0.z, v0.w), pack2(v1.x, v1.y), pack2(v1.z, v1.w));
    }
  } else if constexpr (MODE == G_RWW) {
    float4* W4 = (float4*)((float*)(p.ws + OFF_BUFA) + (size_t)m * 512 + col0);
    const float4* w04 = (const float4*)(p.w0 + col0);
#pragma unroll
    for (int c4 = 0; c4 < 16; ++c4) {
      float4 v = crow4[c4], ww = w04[c4];
      float u[4] = {v.x + ww.x, v.y + ww.y, v.z + ww.z, v.w + ww.w};
#pragma unroll
      for (int e = 0; e < 4; ++e) {
        const float z = -u[e];
        const float sp = fmaxf(z, 0.f) + log1pf(__expf(-fabsf(z)));
        u[e] = __expf(-__expf(-sp - 0.5f));
      }
      W4[c4] = make_float4(u[0], u[1], u[2], u[3]);
    }
  } else if constexpr (MODE == G_RWA) {
    const u16* proj = (const u16*)(p.ws + OFF_PROJ);
    float* prm = (float*)(smem + 128 * 132 * 4);
    if (tid < 128) {
      const int c = tn * 128 + tid;
      prm[tid] = p.mu[512 + c]; prm[128 + tid] = p.k_k[c]; prm[256 + tid] = p.a0[c]; prm[384 + tid] = p.k_a[c];
    }
    __syncthreads();
    const float* pmu = prm + half * 64; const float* pkk = prm + 128 + half * 64;
    const float* pa0 = prm + 256 + half * 64; const float* pka = prm + 384 + half * 64;
    float* AA = aaptr(p.ws, m) + col0;
    float* KP = p.out + (size_t)(m >> 12) * (4096 * 1024) + (size_t)(m & 4095) * 512 + col0;
    float* KK = KP + (size_t)4096 * 512;
    const bool has_prev = (m & (T - 1)) != 0;
    const u16* pc = proj + prow(m) + K_OFF + col0;
    const u16* pp = proj + prow(m - 1) + K_OFF + col0;
    float ss = 0.f;
#pragma unroll 2
    for (int c8 = 0; c8 < 8; ++c8) {
      uint4 cu = *(const uint4*)(pc + c8 * 8);
      uint4 pu = has_prev ? *(const uint4*)(pp + c8 * 8) : make_uint4(0, 0, 0, 0);
      const unsigned cw[4] = {cu.x, cu.y, cu.z, cu.w}, pw[4] = {pu.x, pu.y, pu.z, pu.w};
#pragma unroll
      for (int e = 0; e < 8; ++e) {
        const int c = c8 * 8 + e;
        const float cc = (e & 1) ? hi_bf(cw[e >> 1]) : lo_bf(cw[e >> 1]);
        const float pv = (e & 1) ? hi_bf(pw[e >> 1]) : lo_bf(pw[e >> 1]);
        const float k = cc + (pv - cc) * pmu[c];
        const float kkv = k * pkk[c];
        ss += kkv * kkv;
      }
    }
    const float inv = rsqrtf(fmaxf(ss, 1e-24f));
#pragma unroll 2
    for (int c8 = 0; c8 < 8; ++c8) {
      uint4 cu = *(const uint4*)(pc + c8 * 8);
      uint4 pu = has_prev ? *(const uint4*)(pp + c8 * 8) : make_uint4(0, 0, 0, 0);
      const unsigned cw[4] = {cu.x, cu.y, cu.z, cu.w}, pw[4] = {pu.x, pu.y, pu.z, pu.w};
      float4 v0 = crow4[2 * c8], v1 = crow4[2 * c8 + 1];
      const float av[8] = {v0.x, v0.y, v0.z, v0.w, v1.x, v1.y, v1.z, v1.w};
      float ao[8], kpo[8], kko[8];
#pragma unroll
      for (int e = 0; e < 8; ++e) {
        const int c = c8 * 8 + e;
        const float cc = (e & 1) ? hi_bf(cw[e >> 1]) : lo_bf(cw[e >> 1]);
        const float pv = (e & 1) ? hi_bf(pw[e >> 1]) : lo_bf(pw[e >> 1]);
        const float k = cc + (pv - cc) * pmu[c];
        const float a = sigmoidf_(pa0[c] + av[e]);
        ao[e] = a;
        kko[e] = k * pkk[c] * inv;
        kpo[e] = k * (1.f + (a - 1.f) * pka[c]);
      }
      *(float4*)(AA + c8 * 8) = make_float4(ao[0], ao[1], ao[2], ao[3]);
      *(float4*)(AA + c8 * 8 + 4) = make_float4(ao[4], ao[5], ao[6], ao[7]);
      *(float4*)(KP + c8 * 8) = make_float4(kpo[0], kpo[1], kpo[2], kpo[3]);
      *(float4*)(KP + c8 * 8 + 4) = make_float4(kpo[4], kpo[5], kpo[6], kpo[7]);
      *(float4*)(KK + c8 * 8) = make_float4(kko[0], kko[1], kko[2], kko[3]);
      *(float4*)(KK + c8 * 8 + 4) = make_float4(kko[4], kko[5], kko[6], kko[7]);
    }
  } else if constexpr (MODE == G_CMP) {
    float* pbl = (float*)(smem + 128 * 132 * 4);
    if (tid < 128) {
      const float* pp = (const float*)(p.ws + OFF_PBP) + kv * 32 * 128 + tid;
      float a = 0.f;
#pragma unroll 8
      for (int c = 0; c < 32; ++c) a += pp[c * 128];
      pbl[tid] = a;
    }
    __syncthreads();
    const float* pb = pbl + half * 64;
#pragma unroll
    for (int c4 = 0; c4 < 16; ++c4) {
      float4 v = crow4[c4];
      v.x = gelu_tanh(v.x + pb[c4 * 4 + 0]); v.y = gelu_tanh(v.y + pb[c4 * 4 + 1]);
      v.z = gelu_tanh(v.z + pb[c4 * 4 + 2]); v.w = gelu_tanh(v.w + pb[c4 * 4 + 3]);
      ((float4*)crow)[c4] = v;
    }
    __syncthreads();
    const float* w2 = kv ? p.cv_w2 : p.ck_w2;
    float w2c[64];
#pragma unroll
    for (int j = 0; j < 64; ++j) w2c[j] = w2[j * 64 + lane];
    for (int rr = 0; rr < 32; ++rr) {
      const int lrow = w * 32 + rr;
      const float4* h4 = (const float4*)(Cs + lrow * 132);
      float a = 0.f;
#pragma unroll
      for (int j4 = 0; j4 < 16; ++j4) {
        float4 hv = h4[j4];
        a += hv.x * w2c[4 * j4] + hv.y * w2c[4 * j4 + 1] + hv.z * w2c[4 * j4 + 2] + hv.w * w2c[4 * j4 + 3];
      }
      Cs[lrow * 132 + lane] = a;
    }
#pragma unroll
    for (int j = 0; j < 64; ++j) w2c[j] = w2[(64 + j) * 64 + lane];
    const float gk = p.kc_g[lane];
    u16* kcn = (u16*)(p.ws + OFF_KCN);
    u16* vct = (u16*)(p.ws + OFF_VCT);
    for (int rr = 0; rr < 32; ++rr) {
      const int lrow = w * 32 + rr;
      const float4* h4 = (const float4*)(Cs + lrow * 132 + 64);
      float a = Cs[lrow * 132 + lane];
#pragma unroll
      for (int j4 = 0; j4 < 16; ++j4) {
        float4 hv = h4[j4];
        a += hv.x * w2c[4 * j4] + hv.y * w2c[4 * j4 + 1] + hv.z * w2c[4 * j4 + 2] + hv.w * w2c[4 * j4 + 3];
      }
      const int rem = (tm & 3) * 128 + lrow;
      const float ss = wave_sum(a * a);
      if (rem < 510) {
        const int b = tm >> 2; const int i = rem >> 1, h = rem & 1;
        if (kv == 0) kcn[((size_t)(b * 2 + h) * 256 + i) * 64 + lane] = f2bf(a * rsqrtf(ss * (1.f / 64.f) + 1e-6f) * gk);
        else vct[((size_t)(b * 2 + h) * 64 + lane) * 256 + i] = f2bf(a);
      }
    }
  }
  }
}

DI void vtrans_item(const Params& p, int item, char* smem) {
  const int tb = item & 63, h = (item >> 6) & 1, b = (item >> 7) & 7, which = item >> 10;
  const u16* proj = (const u16*)(p.ws + OFF_PROJ);
  u16* dst = (u16*)(p.ws + (which ? OFF_VWT : OFF_VST)) + (size_t)(b * 2 + h) * 64 * T;
  const int off = (which ? VW_OFF : VS_OFF) + h * 64;
  u16* s = (u16*)smem;
  const int tid = threadIdx.x;
  __syncthreads();
#pragma unroll
  for (int i = 0; i < 2; ++i) {
    const int id = tid + 256 * i; const int t = id >> 3, c = id & 7;
    uint4 v = *(const uint4*)(proj + prow((size_t)(b * T + tb * 64 + t)) + off + c * 8);
    unsigned* sp = (unsigned*)(s + t * 66 + c * 8);
    sp[0] = v.x; sp[1] = v.y; sp[2] = v.z; sp[3] = v.w;
  }
  __syncthreads();
  const int d = tid >> 2, tc = (tid & 3) * 16;
  unsigned pk[8];
#pragma unroll
  for (int e = 0; e < 8; ++e) pk[e] = (unsigned)s[(tc + 2 * e) * 66 + d] | ((unsigned)s[(tc + 2 * e + 1) * 66 + d] << 16);
  uint4* o = (uint4*)(dst + (size_t)d * T + tb * 64 + tc);
  o[0] = make_uint4(pk[0], pk[1], pk[2], pk[3]);
  o[1] = make_uint4(pk[4], pk[5], pk[6], pk[7]);
  __syncthreads();
}

constexpr float L2E = 1.4426950408889634f;
constexpr float NEGB = -1e30f;
constexpr int A_KS = 0;
constexpr int A_VT = 64 * 144;
constexpr int A_IMP = 2 * 64 * 144;
constexpr int A_SEL = A_IMP + 32 * 68 * 4;
constexpr int A_JL = A_SEL + 32 * 8 + 16;
constexpr int A_OUT = A_JL + 64;
constexpr int A_END = A_OUT + 4 * 32 * 144;
static_assert(A_END <= 73728 - 16, "lds");

struct TileRegs { uint4 k0, k1, v0, v1; };
DI TileRegs tile_issue(const u16* kp, size_t kld, const u16* vp, size_t vld) {
  const int tid = launder(threadIdx.x);
  TileRegs tr;
  tr.k0 = *(const uint4*)(kp + (size_t)(tid >> 3) * kld + (tid & 7) * 8);
  tr.k1 = *(const uint4*)(kp + (size_t)((tid >> 3) + 32) * kld + (tid & 7) * 8);
  tr.v0 = *(const uint4*)(vp + (size_t)(tid >> 3) * vld + (tid & 7) * 8);
  tr.v1 = *(const uint4*)(vp + (size_t)((tid >> 3) + 32) * vld + (tid & 7) * 8);
  return tr;
}
DI void tile_commit(const TileRegs tr, char* smem) {
  const int tid = launder(threadIdx.x);
  *(uint4*)(smem + A_KS + (tid >> 3) * 144 + (tid & 7) * 16) = tr.k0;
  *(uint4*)(smem + A_KS + ((tid >> 3) + 32) * 144 + (tid & 7) * 16) = tr.k1;
  *(uint4*)(smem + A_VT + (tid >> 3) * 144 + (tid & 7) * 16) = tr.v0;
  *(uint4*)(smem + A_VT + ((tid >> 3) + 32) * 144 + (tid & 7) * 16) = tr.v1;
}

template <class PF, class CF> DI void run_tiles(char* smem, int n, PF issue_i, CF comp) {
  TileRegs ta = issue_i(0);
  TileRegs tb = issue_i(n > 1 ? 1 : 0);
  for (int i = 0; i < n; i += 2) {
    __syncthreads();
    tile_commit(ta, smem);
    __syncthreads();
    if (i + 2 < n) ta = issue_i(i + 2);
    comp(i);
    if (i + 1 >= n) break;
    __syncthreads();
    tile_commit(tb, smem);
    __syncthreads();
    if (i + 3 < n) tb = issue_i(i + 3);
    comp(i + 1);
  }
}

DI constexpr int kappa(int it, int e) { return it * 32 + 8 * (e >> 2) + (e & 3); }

struct BiasC { float sq1, sq2, sq3, sg[8]; };
DI float sgpr_f(float x) { return __int_as_float(__builtin_amdgcn_readfirstlane(__float_as_int(x))); }
DI float pow2_scale(float c, int k) { return c == 0.f ? 0.f : __int_as_float(__float_as_int(c) - (k << 23)); }
template <int KS> DI BiasC make_bias(int k) {
  BiasC c;
  c.sq1 = pow2_scale((float)KS, k); c.sq2 = pow2_scale(2.f * KS, k); c.sq3 = pow2_scale(3.f * KS, k);
#pragma unroll
  for (int i = 0; i < 8; ++i) c.sg[i] = pow2_scale((float)(KS * (32 * (i >> 2) + 8 * (i & 3))), k);
  return c;
}
DI void qk_scores(const char* Ks, const bf16x8 (&qf)[4], f32x16 (&S)[2], float bbase, const BiasC& bc, int lane) {
  lane = launder(lane);
  const int r = lane & 31, hf = lane >> 5;
#pragma unroll
  for (int it = 0; it < 2; ++it)
#pragma unroll
    for (int a = 0; a < 4; ++a) {
      const float base = bbase + bc.sg[it * 4 + a];
      S[it][4 * a] = base; S[it][4 * a + 1] = base + bc.sq1; S[it][4 * a + 2] = base + bc.sq2; S[it][4 * a + 3] = base + bc.sq3;
    }
#pragma unroll
  for (int s = 0; s < 4; ++s)
#pragma unroll
    for (int it = 0; it < 2; ++it) {
      const bf16x8 kf = *(const bf16x8*)(Ks + (it * 32 + r) * 144 + s * 32 + hf * 16);
      S[it] = MFMA(kf, qf[s], S[it]);
    }
}

template <int KS, int MASK> DI bool valid_d(int delta, int it, int e) {
  const int d = delta - KS * kappa(it, e);
  if constexpr (MASK == 1) return d >= 0;
  if constexpr (MASK == 2) return d < 512;
  return true;
}

template <int KS, int MASK>
DI float softmax_step(f32x16 (&S)[2], int delta, float& mrun, float& lrun) {
  float mx = mrun;
#pragma unroll
  for (int it = 0; it < 2; ++it)
#pragma unroll
    for (int e = 0; e < 16; ++e) {
      if constexpr (MASK != 0) S[it][e] = valid_d<KS, MASK>(delta, it, e) ? S[it][e] : NEGB;
      mx = fmaxf(mx, S[it][e]);
    }
  mx = fmaxf(mx, __shfl_xor(mx, 32));
  const float alpha = __builtin_amdgcn_exp2f((mrun - mx) * L2E);
  mrun = mx;
  const float mxs = mx * L2E;
  float ls = 0.f;
#pragma unroll
  for (int it = 0; it < 2; ++it)
#pragma unroll
    for (int e = 0; e < 16; ++e) {
      float pe = __builtin_amdgcn_exp2f(fmaf(S[it][e], L2E, -mxs));
      if constexpr (MASK != 0) pe = valid_d<KS, MASK>(delta, it, e) ? pe : 0.f;
      S[it][e] = pe;
      ls += pe;
    }
  lrun = lrun * alpha + ls;
  return alpha;
}

DI bf16x8 pack8(const f32x16& x, int s2) {
  unsigned a = pack2(x[8 * s2 + 0], x[8 * s2 + 1]), b = pack2(x[8 * s2 + 2], x[8 * s2 + 3]);
  unsigned c = pack2(x[8 * s2 + 4], x[8 * s2 + 5]), d = pack2(x[8 * s2 + 6], x[8 * s2 + 7]);
  uint4 u = make_uint4(a, b, c, d);
  return __builtin_bit_cast(bf16x8, u);
}

DI void pv_accum(const char* VTs, const f32x16 (&P)[2], f32x16 (&O)[2], int lane) {
  lane = launder(lane);
  const int r = lane & 31, hf = lane >> 5;
#pragma unroll
  for (int it = 0; it < 2; ++it)
#pragma unroll
    for (int s2 = 0; s2 < 2; ++s2) {
      const bf16x8 pf = pack8(P[it], s2);
#pragma unroll
      for (int dt = 0; dt < 2; ++dt) {
        const char* ptr = VTs + (dt * 32 + r) * 144 + (it * 32 + 16 * s2 + 4 * hf) * 2;
        const s16x4 lo = *(const s16x4*)ptr;
        const s16x4 hi = *(const s16x4*)(ptr + 16);
        const bf16x8 vf = __builtin_shufflevector(lo, hi, 0, 1, 2, 3, 4, 5, 6, 7);
        O[dt] = MFMA(vf, pf, O[dt]);
      }
    }
}

DI void zero_tiles(f32x16 (&O)[2]) {
#pragma unroll
  for (int a = 0; a < 2; ++a)
#pragma unroll
    for (int e = 0; e < 16; ++e) O[a][e] = 0.f;
}

template <bool FIRST>
DI void out_accum(char* outw, const f32x16 (&O)[2], float scale, int lane) {
  lane = launder(lane);
  const int r = lane & 31, hf = lane >> 5;
#pragma unroll
  for (int dt = 0; dt < 2; ++dt)
#pragma unroll
    for (int a = 0; a < 4; ++a) {
      uint2* ptr = (uint2*)(outw + r * 144 + (dt * 32 + 8 * a + 4 * hf) * 2);
      float v0 = O[dt][4 * a] * scale, v1 = O[dt][4 * a + 1] * scale;
      float v2 = O[dt][4 * a + 2] * scale, v3 = O[dt][4 * a + 3] * scale;
      if constexpr (!FIRST) {
        const uint2 old = *ptr;
        v0 += lo_bf(old.x); v1 += hi_bf(old.x); v2 += lo_bf(old.y); v3 += hi_bf(old.y);
      }
      *ptr = make_uint2(pack2(v0, v1), pack2(v2, v3));
    }
}

DI void cmp_probs(f32x16 (&S)[2], int delta, float mfin, float invl) {
  const float mxs = mfin * L2E;
#pragma unroll
  for (int it = 0; it < 2; ++it)
#pragma unroll
    for (int e = 0; e < 16; ++e) {
      const float pe = __builtin_amdgcn_exp2f(fmaf(S[it][e], L2E, -mxs)) * invl;
      S[it][e] = valid_d<16, 1>(delta, it, e) ? pe : 0.f;
    }
}

DI void attn_item(const Params& p, int b, int item, char* smem) {
  const int qh = 127 - (item >> 1);
  const int qb = qh >> 1;
  const int h = item & 1;
  const int tid = threadIdx.x, lane = tid & 63;
  const int g = __builtin_amdgcn_readfirstlane(tid >> 6);
  const int r = lane & 31, hf = lane >> 5;
  const int head = h * 4 + g;
  const float slope = sgpr_f(__builtin_amdgcn_exp2f(-(float)(head + 1)));
  const BiasC bc1 = make_bias<1>(head + 1), bc16 = make_bias<16>(head + 1);
  const u16* proj = (const u16*)(p.ws + OFF_PROJ);
  const int q0 = qh * 32;
  const size_t m0 = (size_t)b * T + (size_t)q0;
  const int tq = q0 + r;
  char* Ks = smem + A_KS;
  char* VTs = smem + A_VT;
  float* IMPs = (float*)(smem + A_IMP);
  unsigned long long* SELM = (unsigned long long*)(smem + A_SEL);
  unsigned* UN = (unsigned*)(smem + A_SEL + 32 * 8);
  char* outw = smem + A_OUT + g * 32 * 144;

  bf16x8 qf[4];
  float gate[3];
  {
    const u16* qrow = proj + prow(m0 + r);
#pragma unroll
    for (int s = 0; s < 4; ++s) qf[s] = *(const bf16x8*)(qrow + head * 64 + s * 16 + hf * 8);
#pragma unroll
    for (int br = 0; br < 3; ++br) gate[br] = bf2f(qrow[GL_OFF + head * 3 + br]);
  }
  if (tid < 2) UN[tid] = 0;

  f32x16 S[2], O[2];
  float mrun, lrun;

  const int nkt = ((q0 >> 4) + 1 + 63) >> 6;
  const u16* kc = (const u16*)(p.ws + OFF_KCN) + (size_t)(b * 2 + h) * 256 * 64;
  const u16* vc = (const u16*)(p.ws + OFF_VCT) + (size_t)(b * 2 + h) * 64 * 256;
  mrun = NEGB; lrun = 0.f;
  auto cmp_issue = [&](int kt) { return tile_issue(kc + (size_t)kt * 64 * 64, 64, vc + kt * 64, 256); };
  run_tiles(smem, nkt, cmp_issue, [&](int kt) {
    const int delta = tq - 31 - 1024 * kt - 64 * hf;
    qk_scores(Ks, qf, S, -slope * (float)delta, bc16, lane);
    softmax_step<16, 1>(S, delta, mrun, lrun);
  });
  float invl, mfin;
  {
    const float lt = lrun + __shfl_xor(lrun, 32);
    invl = lt > 0.f ? 1.f / lt : 0.f;
    mfin = mrun;
  }
  zero_tiles(O);
  run_tiles(smem, nkt, cmp_issue, [&](int kt) {
    const int delta = tq - 31 - 1024 * kt - 64 * hf;
    qk_scores(Ks, qf, S, -slope * (float)delta, bc16, lane);
    cmp_probs(S, delta, mfin, invl);
    pv_accum(VTs, S, O, lane);
  });
  out_accum<true>(outw, O, gate[0], lane);
  zero_tiles(O);
  run_tiles(smem, nkt, cmp_issue, [&](int kt) {
    const int delta = tq - 31 - 1024 * kt - 64 * hf;
    qk_scores(Ks, qf, S, -slope * (float)delta, bc16, lane);
    cmp_probs(S, delta, mfin, invl);
#pragma unroll
    for (int it = 0; it < 2; ++it)
#pragma unroll
      for (int s2 = 0; s2 < 2; ++s2) {
        const bf16x8 pf = pack8(S[it], s2);
#pragma unroll
        for (int dt = 0; dt < 2; ++dt) {
          const int j = dt * 32 + r;
          bf16x8 ov;
          const int nb0 = 64 * kt + 4 * hf - 4 * j + 1;
#pragma unroll
          for (int e = 0; e < 8; ++e) {
            const unsigned dn = (unsigned)(nb0 + it * 32 + 16 * s2 + 8 * (e >> 2) + (e & 3));
            ov[e] = (dn <= 4u) ? (short)0x3C00 : (short)0;
          }
          O[dt] = MFMA(ov, pf, O[dt]);
        }
      }
  });
  for (int round = 0; round < 4; ++round) {
    __syncthreads();
    if (g == round) {
#pragma unroll
      for (int dt = 0; dt < 2; ++dt)
#pragma unroll
        for (int a = 0; a < 4; ++a) {
          float4* ptr = (float4*)(IMPs + r * 68 + dt * 32 + 8 * a + 4 * hf);
          float4 v = make_float4(O[dt][4 * a], O[dt][4 * a + 1], O[dt][4 * a + 2], O[dt][4 * a + 3]);
          if (round != 0) { const float4 o = *ptr; v.x += o.x; v.y += o.y; v.z += o.z; v.w += o.w; }
          *ptr = v;
        }
    }
  }
  __syncthreads();
  {
    const int t = tid >> 3, j0 = (tid & 7) * 8;
#pragma unroll
    for (int e = 0; e < 8; ++e) {
      const int j = j0 + e;
      float v = IMPs[t * 68 + j];
      const bool forced = (j == 0) || (j == qb) || (j == qb - 1);
      v = forced ? 1e6f : (j > qb ? NEGB : v);
      IMPs[t * 68 + j] = v;
    }
  }
  __syncthreads();
  for (int i = 0; i < 8; ++i) {
    const int t = g * 8 + i;
    const float vj = IMPs[t * 68 + lane];
    int rank = 0;
#pragma unroll 1
    for (int c4 = 0; c4 < 16; ++c4) {
      const float4 v = *(const float4*)(IMPs + t * 68 + c4 * 4);
      const int rel = lane - c4 * 4;
      rank += (v.x > vj || (v.x == vj && 0 < rel)) ? 1 : 0;
      rank += (v.y > vj || (v.y == vj && 1 < rel)) ? 1 : 0;
      rank += (v.z > vj || (v.z == vj && 2 < rel)) ? 1 : 0;
      rank += (v.w > vj || (v.w == vj && 3 < rel)) ? 1 : 0;
    }
    const unsigned long long msk = __ballot(rank < 16);
    if (lane == 0) {
      SELM[t] = msk;
      atomicOr(&UN[0], (unsigned)(msk & 0xffffffffull));
      atomicOr(&UN[1], (unsigned)(msk >> 32));
    }
  }
  __syncthreads();
  const unsigned long long selm = SELM[r];
  unsigned long long un;
  {
    unsigned u0 = __builtin_amdgcn_readfirstlane(UN[0]), u1 = __builtin_amdgcn_readfirstlane(UN[1]);
    un = (unsigned long long)u0 | ((unsigned long long)u1 << 32);
    un &= (qb == 63) ? ~0ull : ((1ull << (qb + 1)) - 1ull);
  }

  {
    unsigned char* JL = (unsigned char*)(smem + A_JL);
    if (tid < 64 && ((un >> tid) & 1ull)) JL[__builtin_popcountll(tid == 63 ? 0ull : (un >> (tid + 1)))] = (unsigned char)tid;
    const int nsel = __builtin_popcountll(un);
    __syncthreads();
    const u16* ksb = proj + prow((size_t)b * T) + KS_OFF + h * 64;
    const u16* vsb = (const u16*)(p.ws + OFF_VST) + (size_t)(b * 2 + h) * 64 * T;
    mrun = NEGB; lrun = 0.f;
    zero_tiles(O);
    run_tiles(smem, nsel,
      [&](int i) { const int j = JL[i]; return tile_issue(ksb + (size_t)j * 64 * NP, NP, vsb + j * 64, T); },
      [&](int i) {
        const int j = __builtin_amdgcn_readfirstlane((int)JL[i]);
        const int delta = tq - j * 64 - 4 * hf;
        const bool sel = (selm >> j) & 1ull;
        qk_scores(Ks, qf, S, sel ? -slope * (float)delta : NEGB, bc1, lane);
        float alpha;
        if (j == qb) alpha = softmax_step<1, 1>(S, delta, mrun, lrun);
        else alpha = softmax_step<1, 0>(S, delta, mrun, lrun);
        if (__builtin_amdgcn_ballot_w64(alpha != 1.f) != 0ull) {
#pragma unroll
          for (int dt = 0; dt < 2; ++dt)
#pragma unroll
            for (int e = 0; e < 16; ++e) O[dt][e] *= alpha;
        }
        pv_accum(VTs, S, O, lane);
      });
    const float lt = lrun + __shfl_xor(lrun, 32);
    out_accum<false>(outw, O, lt > 0.f ? gate[1] / lt : 0.f, lane);
  }
  {
    const u16* kwb = proj + prow((size_t)b * T) + KW_OFF + h * 64;
    const u16* vwb = (const u16*)(p.ws + OFF_VWT) + (size_t)(b * 2 + h) * 64 * T;
    mrun = NEGB; lrun = 0.f;
    zero_tiles(O);
    const int jlo = qb - 8 > 0 ? qb - 8 : 0;
    run_tiles(smem, qb - jlo + 1,
      [&](int i) { const int j = qb - i; return tile_issue(kwb + (size_t)j * 64 * NP, NP, vwb + j * 64, T); },
      [&](int i) {
        const int j = qb - i;
        const int delta = tq - j * 64 - 4 * hf;
        qk_scores(Ks, qf, S, -slope * (float)delta, bc1, lane);
        float alpha;
        if (j == qb) alpha = softmax_step<1, 1>(S, delta, mrun, lrun);
        else if (j == qb - 8) alpha = softmax_step<1, 2>(S, delta, mrun, lrun);
        else alpha = softmax_step<1, 0>(S, delta, mrun, lrun);
        if (__builtin_amdgcn_ballot_w64(alpha != 1.f) != 0ull) {
#pragma unroll
          for (int dt = 0; dt < 2; ++dt)
#pragma unroll
            for (int e = 0; e < 16; ++e) O[dt][e] *= alpha;
        }
        pv_accum(VTs, S, O, lane);
      });
    const float lt = lrun + __shfl_xor(lrun, 32);
    out_accum<false>(outw, O, lt > 0.f ? gate[2] / lt : 0.f, lane);
  }
  __syncthreads();
  {
    u16* mix = (u16*)(p.ws + OFF_MIX);
#pragma unroll
    for (int i = 0; i < 4; ++i) {
      const int t = (lane >> 3) + 8 * i, c = lane & 7;
      const uint4 v = *(const uint4*)(outw + t * 144 + c * 16);
      *(uint4*)(mix + (m0 + t) * 1024 + head * 64 + c * 8) = v;
    }
  }
  __syncthreads();
}

constexpr int SC = 16;
DI void scan_item(const Params& p, int b, int h, int half, char* smem, unsigned* pgen, unsigned kp) {
  const int tid = threadIdx.x;
  const int rp = tid >> 3, cg = tid & 7;
  float* Rl = (float*)smem;
  float* Wl = Rl + SC * 64;
  float* Kl = Wl + SC * 64;
  float* Vl = Kl + SC * 64;
  float* Al = Vl + SC * 64;
  float* Bl = Al + SC * 64;
  float* Yl = Bl + SC * 64;
  float* BON = Yl + SC * 64;
  const u16* proj = (const u16*)(p.ws + OFF_PROJ);
  const float* Wg = (const float*)(p.ws + OFF_BUFA);
  const float* KPg = p.out + (size_t)b * (4096 * 1024) - (size_t)b * T * 512;
  const float* KKg = KPg + (size_t)4096 * 512;
  u16* mix = (u16*)(p.ws + OFF_MIX);
  const int ls = tid >> 4, lc = (tid & 15) * 4;
  const int hc = h * 64 + lc;

  f32x2 St[4];
#pragma unroll
  for (int i = 0; i < 4; ++i) St[i] = (f32x2){0.f, 0.f};

  float* CT = BON + 64;
  __syncthreads();
  if (tid < 64) {
    CT[tid] = p.mu[h * 64 + tid]; CT[64 + tid] = p.mu[1024 + h * 64 + tid]; CT[128 + tid] = p.r_k[h * 64 + tid];
    CT[192 + tid] = p.lnx_w[h * 64 + tid]; CT[256 + tid] = p.lnx_b[h * 64 + tid];
  }
  struct ScanRaw { float4 w, k, kk, a; uint2 rc, vc, rp, vp; };
  float4 pw, pk, pkk, pa, pr, pv;
  float pbon;
  auto prefetch = [&](int c, ScanRaw& R) {
    const int t = c * SC + ls;
    const size_t m = (size_t)b * T + t;
    R.w = *(const float4*)(Wg + m * 512 + hc);
    R.k = *(const float4*)(KPg + m * 512 + hc);
    R.kk = *(const float4*)(KKg + m * 512 + hc);
    R.a = *(const float4*)(aaptr(p.ws, m) + hc);
    R.rc = *(const uint2*)(proj + prow(m) + R_OFF + hc);
    R.vc = *(const uint2*)(proj + prow(m) + V_OFF + hc);
    R.rp = make_uint2(0, 0); R.vp = make_uint2(0, 0);
    if (t > 0) { R.rp = *(const uint2*)(proj + prow(m - 1) + R_OFF + hc); R.vp = *(const uint2*)(proj + prow(m - 1) + V_OFF + hc); }
  };
  auto convert = [&](const ScanRaw& R) {
    const float4 mu_r = *(const float4*)(CT + lc);
    const float4 mu_v = *(const float4*)(CT + 64 + lc);
    const float4 rk = *(const float4*)(CT + 128 + lc);
    pw = R.w; pk = R.k; pkk = R.kk; pa = R.a;
    float c0, p0;
    c0 = lo_bf(R.rc.x); p0 = lo_bf(R.rp.x); pr.x = c0 + (p0 - c0) * mu_r.x;
    c0 = hi_bf(R.rc.x); p0 = hi_bf(R.rp.x); pr.y = c0 + (p0 - c0) * mu_r.y;
    c0 = lo_bf(R.rc.y); p0 = lo_bf(R.rp.y); pr.z = c0 + (p0 - c0) * mu_r.z;
    c0 = hi_bf(R.rc.y); p0 = hi_bf(R.rp.y); pr.w = c0 + (p0 - c0) * mu_r.w;
    c0 = lo_bf(R.vc.x); p0 = lo_bf(R.vp.x); pv.x = c0 + (p0 - c0) * mu_v.x;
    c0 = hi_bf(R.vc.x); p0 = hi_bf(R.vp.x); pv.y = c0 + (p0 - c0) * mu_v.y;
    c0 = lo_bf(R.vc.y); p0 = lo_bf(R.vp.y); pv.z = c0 + (p0 - c0) * mu_v.z;
    c0 = hi_bf(R.vc.y); p0 = hi_bf(R.vp.y); pv.w = c0 + (p0 - c0) * mu_v.w;
    pbon = row16_sum(pr.x * pk.x * rk.x + pr.y * pk.y * rk.y + pr.z * pk.z * rk.z + pr.w * pk.w * rk.w);
  };
  auto override_t0 = [&]() {
    const float* t0 = (const float*)(p.ws + OFF_T0) + (size_t)b * 17 * 64;
    const float4 r0 = *(const float4*)(t0 + h * 64 + lc);
    const float4 k0 = *(const float4*)(t0 + (8 + h) * 64 + lc);
    float av[4] = {p.a0[hc], p.a0[hc + 1], p.a0[hc + 2], p.a0[hc + 3]};
    for (int j = 0; j < 64; ++j) {
      const float xj = t0[16 * 64 + j];
      const float4 a2r = *(const float4*)(p.a2 + (size_t)j * 512 + hc);
      av[0] += xj * a2r.x; av[1] += xj * a2r.y; av[2] += xj * a2r.z; av[3] += xj * a2r.w;
    }
    const float4 kkw = *(const float4*)(p.k_k + hc);
    const float4 kaw = *(const float4*)(p.k_a + hc);
    const float4 rk = *(const float4*)(CT + 128 + lc);
    const float kv[4] = {k0.x, k0.y, k0.z, k0.w}, kkc[4] = {kkw.x, kkw.y, kkw.z, kkw.w}, kac[4] = {kaw.x, kaw.y, kaw.z, kaw.w};
    float kkv[4], kpv[4], aa[4], ssq = 0.f;
#pragma unroll
    for (int e = 0; e < 4; ++e) { aa[e] = sigmoidf_(av[e]); kkv[e] = kv[e] * kkc[e]; ssq += kkv[e] * kkv[e]; kpv[e] = kv[e] * (1.f + (aa[e] - 1.f) * kac[e]); }
    ssq = row16_sum(ssq);
    const float inv = rsqrtf(fmaxf(ssq, 1e-24f));
    pr = r0;
    pk = make_float4(kpv[0], kpv[1], kpv[2], kpv[3]);
    pkk = make_float4(kkv[0] * inv, kkv[1] * inv, kkv[2] * inv, kkv[3] * inv);
    pa = make_float4(aa[0], aa[1], aa[2], aa[3]);
    pbon = row16_sum(pr.x * pk.x * rk.x + pr.y * pk.y * rk.y + pr.z * pk.z * rk.z + pr.w * pk.w * rk.w);
  };
  auto chunk = [&](int c, ScanRaw& R) {
    __syncthreads();
    convert(R);
    if (c == 0 && ls == 0) override_t0();
    *(float4*)(Rl + ls * 64 + lc) = pr;
    *(float4*)(Wl + ls * 64 + lc) = pw;
    *(float4*)(Kl + ls * 64 + lc) = pk;
    *(float4*)(Vl + ls * 64 + lc) = pv;
    *(float4*)(Al + ls * 64 + lc) = make_float4(-pkk.x, -pkk.y, -pkk.z, -pkk.w);
    *(float4*)(Bl + ls * 64 + lc) = make_float4(pkk.x * pa.x, pkk.y * pa.y, pkk.z * pa.z, pkk.w * pa.w);
    if ((tid & 15) == 0) BON[ls] = pbon;
    __syncthreads();
    if (c + 2 == (T / SC) / 4) {
      if (tid == 0) {
        while (__hip_atomic_load(pgen, __ATOMIC_RELAXED, __HIP_MEMORY_SCOPE_AGENT) < kp) __builtin_amdgcn_s_sleep(2);
        __builtin_amdgcn_fence(__ATOMIC_ACQUIRE, "agent");
        asm volatile("s_waitcnt vmcnt(0)" ::: "memory");
      }
      __syncthreads();
    }
    if (c + 2 < T / SC) prefetch(c + 2, R);
#pragma unroll 1
    for (int sg = 0; sg < SC; sg += 4) {
      float yy[4];
#pragma unroll
      for (int s4 = 0; s4 < 4; ++s4) {
        const int s = sg + s4;
        const f32x2* a2 = (const f32x2*)(Al + s * 64 + cg * 8);
        const f32x2* w2 = (const f32x2*)(Wl + s * 64 + cg * 8);
        const f32x2* b2 = (const f32x2*)(Bl + s * 64 + cg * 8);
        const f32x2* k2 = (const f32x2*)(Kl + s * 64 + cg * 8);
        const f32x2* r2 = (const f32x2*)(Rl + s * 64 + cg * 8);
        f32x2 o[20];
#pragma unroll
        for (int i = 0; i < 4; ++i) { o[i] = a2[i]; o[4 + i] = w2[i]; o[8 + i] = b2[i]; o[12 + i] = k2[i]; o[16 + i] = r2[i]; }
        const float vr = Vl[s * 64 + 32 * half + rp];
        f32x2 p0 = St[0] * o[0], p1 = St[1] * o[1];
        p0 = __builtin_elementwise_fma(St[2], o[2], p0); p1 = __builtin_elementwise_fma(St[3], o[3], p1);
        const float sa = oct_sum((p0.x + p0.y) + (p1.x + p1.y));
        const f32x2 sv = {sa, sa}, vv = {vr, vr};
        f32x2 y0 = {0.f, 0.f}, y1 = {0.f, 0.f};
#pragma unroll
        for (int i = 0; i < 4; i += 2) {
          St[i] = __builtin_elementwise_fma(St[i], o[4 + i], __builtin_elementwise_fma(sv, o[8 + i], vv * o[12 + i]));
          St[i + 1] = __builtin_elementwise_fma(St[i + 1], o[5 + i], __builtin_elementwise_fma(sv, o[9 + i], vv * o[13 + i]));
          y0 = __builtin_elementwise_fma(St[i], o[16 + i], y0);
          y1 = __builtin_elementwise_fma(St[i + 1], o[17 + i], y1);
        }
        yy[s4] = oct_sum((y0.x + y0.y) + (y1.x + y1.y));
      }
      if (cg == 0) {
#pragma unroll
        for (int s4 = 0; s4 < 4; ++s4) Yl[(sg + s4) * 32 + rp] = yy[s4];
      }
    }
    __syncthreads();
    {
      const int t = c * SC + ls;
      const size_t m = (size_t)b * T + t;
      const int j2 = (tid & 15) * 2;
      const f32x2 y2 = *(const f32x2*)(Yl + ls * 32 + j2);
      *(unsigned*)(mix + m * 1024 + 512 + h * 64 + 32 * half + j2) = pack2(y2.x, y2.y);
      if (half == 0 && (tid & 15) == 0) ((float*)(p.ws + OFF_BON))[m * 8 + h] = BON[ls];
    }
  };
  ScanRaw RA, RB;
  prefetch(0, RA);
  prefetch(1, RB);
  __builtin_amdgcn_s_setprio(3);
#pragma unroll 1
  for (int c = 0; c < T / SC; c += 2) {
    chunk(c, RA);
    chunk(c + 1, RB);
  }
  __builtin_amdgcn_s_setprio(0);
  __syncthreads();
}


struct GnRaw { uint2 yr, vc, vp, gg; float bon; };
DI GnRaw gn_load(const Params& p, size_t m, int ml, int h, int hc) {
  const u16* proj = (const u16*)(p.ws + OFF_PROJ);
  const u16* mix = (const u16*)(p.ws + OFF_MIX);
  GnRaw r;
  r.yr = *(const uint2*)(mix + m * 1024 + 512 + hc);
  r.vc = *(const uint2*)(proj + prow(m) + V_OFF + hc);
  r.vp = make_uint2(0, 0);
  if (ml > 0) r.vp = *(const uint2*)(proj + prow(m - 1) + V_OFF + hc);
  r.bon = ((const float*)(p.ws + OFF_BON))[m * 8 + h];
  r.gg = *(const uint2*)((const u16*)(p.ws + OFF_G) + m * 512 + hc);
  return r;
}
DI void gn_finish(const Params& p, const GnRaw& r, size_t m, int hc, const float4& mv, const float4& lw, const float4& lb) {
  u16* yp = (u16*)(p.ws + OFF_MIX) + m * 1024 + 512 + hc;
  const float y0 = lo_bf(r.yr.x), y1 = hi_bf(r.yr.x), y2 = lo_bf(r.yr.y), y3 = hi_bf(r.yr.y);
  const float mean = row16_sum(y0 + y1 + y2 + y3) * (1.f / 64.f);
  const float d0 = y0 - mean, d1 = y1 - mean, d2 = y2 - mean, d3 = y3 - mean;
  const float var = row16_sum(d0 * d0 + d1 * d1 + d2 * d2 + d3 * d3) * (1.f / 64.f);
  const float rs = rsqrtf(var + 64e-5f);
  float c0, p0;
  c0 = lo_bf(r.vc.x); p0 = lo_bf(r.vp.x); const float v0 = c0 + (p0 - c0) * mv.x;
  c0 = hi_bf(r.vc.x); p0 = hi_bf(r.vp.x); const float v1 = c0 + (p0 - c0) * mv.y;
  c0 = lo_bf(r.vc.y); p0 = lo_bf(r.vp.y); const float v2 = c0 + (p0 - c0) * mv.z;
  c0 = hi_bf(r.vc.y); p0 = hi_bf(r.vp.y); const float v3 = c0 + (p0 - c0) * mv.w;
  const float o0 = (d0 * rs * lw.x + lb.x + r.bon * v0) * lo_bf(r.gg.x);
  const float o1 = (d1 * rs * lw.y + lb.y + r.bon * v1) * hi_bf(r.gg.x);
  const float o2 = (d2 * rs * lw.z + lb.z + r.bon * v2) * lo_bf(r.gg.y);
  const float o3 = (d3 * rs * lw.w + lb.w + r.bon * v3) * hi_bf(r.gg.y);
  *(uint2*)yp = make_uint2(pack2(o0, o1), pack2(o2, o3));
}
DI void gn_item(const Params& p, int b, int idx) {
  const int tid = threadIdx.x;
  const int lc = (tid & 15) * 4;
  const int qa = idx * 16 + (tid >> 4), qb2 = qa + 16384;
  const int mla = qa >> 3, ha = qa & 7, mlb = qb2 >> 3, hb = qb2 & 7;
  const int hc = ha * 64 + lc;
  const size_t ma = (size_t)b * T + mla, mb = (size_t)b * T + mlb;
  const GnRaw ra = gn_load(p, ma, mla, ha, hc);
  const GnRaw rb = gn_load(p, mb, mlb, hb, hc);
  const float4 mv = *(const float4*)(p.mu + 1024 + hc);
  const float4 lw = *(const float4*)(p.lnx_w + hc);
  const float4 lb = *(const float4*)(p.lnx_b + hc);
  gn_finish(p, ra, ma, hc, mv, lw, lb);
  gn_finish(p, rb, mb, hc, mv, lw, lb);
}

DI void grid_barrier(unsigned* ctr, unsigned target) {
  asm volatile("s_waitcnt vmcnt(0)" ::: "memory");
  __syncthreads();
  if (threadIdx.x == 0) {
    __builtin_amdgcn_s_waitcnt(0);
    __builtin_amdgcn_fence(__ATOMIC_RELEASE, "agent");
    asm volatile("s_waitcnt vmcnt(0)" ::: "memory");
    __hip_atomic_fetch_add(ctr, 1u, __ATOMIC_RELAXED, __HIP_MEMORY_SCOPE_AGENT);
    while (__hip_atomic_load(ctr, __ATOMIC_RELAXED, __HIP_MEMORY_SCOPE_AGENT) < target) __builtin_amdgcn_s_sleep(1);
    __builtin_amdgcn_fence(__ATOMIC_ACQUIRE, "agent");
    asm volatile("s_waitcnt vmcnt(0)" ::: "memory");
  }
  __syncthreads();
}

DI void xcd_barrier(unsigned* ctr, unsigned cnt, unsigned k) {
  asm volatile("s_waitcnt vmcnt(0)" ::: "memory");
  __syncthreads();
  if (threadIdx.x == 0) {
    __builtin_amdgcn_s_waitcnt(0);
    const unsigned old = __hip_atomic_fetch_add(ctr, 1u, __ATOMIC_RELAXED, __HIP_MEMORY_SCOPE_AGENT);
    if (old + 1u == cnt * k) {
      __builtin_amdgcn_fence(__ATOMIC_RELEASE, "agent");
      asm volatile("s_waitcnt vmcnt(0)" ::: "memory");
      __hip_atomic_fetch_add(ctr + 1, 1u, __ATOMIC_RELAXED, __HIP_MEMORY_SCOPE_AGENT);
    } else {
      while (__hip_atomic_load(ctr + 1, __ATOMIC_RELAXED, __HIP_MEMORY_SCOPE_AGENT) < k) __builtin_amdgcn_s_sleep(1);
    }
    __builtin_amdgcn_fence(__ATOMIC_ACQUIRE, "agent");
    asm volatile("s_waitcnt vmcnt(0)" ::: "memory");
  }
  __syncthreads();
}

DI void t0_item(const Params& p, int item, char* smem) {
  const int b = item / 17, grp = item - b * 17;
  const int tid = threadIdx.x;
  float* xs = (float*)smem;
  float* red = xs + 1024;
  __syncthreads();
  const float* xr = p.x + (size_t)b * T * 1024;
  float ss = 0.f;
  for (int i = tid; i < 1024; i += 256) { const float v = xr[i]; ss += v * v; }
  ss = wave_sum(ss);
  __syncthreads();
  if ((tid & 63) == 0) red[tid >> 6] = ss;
  __syncthreads();
  const float sc = rsqrtf((red[0] + red[1] + red[2] + red[3]) * (1.f / 1024.f) + 1e-6f);
  for (int i = tid; i < 1024; i += 256) xs[i] = xr[i] * sc * p.ln_mix_g[i];
  __syncthreads();
  const int c = tid & 63, kp = tid >> 6;
  const int rc = grp < 8 ? grp * 64 + c : (grp < 16 ? 512 + (grp - 8) * 64 + c : 1600 + c);
  const float* wc = p.w_in + 1304 + rc;
  float a = 0.f;
#pragma unroll 8
  for (int k = kp * 256; k < kp * 256 + 256; ++k) a += xs[k] * wc[(size_t)k * 3096];
  __syncthreads();
  red[tid] = a;
  __syncthreads();
  if (tid < 64) {
    const float v = red[tid] + red[tid + 64] + red[tid + 128] + red[tid + 192];
    ((float*)(p.ws + OFF_T0))[(size_t)(b * 17 + grp) * 64 + tid] = v * (1.f - p.mu[rc]);
  }
  __syncthreads();
}


struct XcdInfo { int pi, npop, rank, cnt; };
DI XcdInfo xcd_setup(unsigned* ctrbase, char* smem) {
  int* sx = (int*)(smem + 73728 - 64);
  if (threadIdx.x == 0) {
    const unsigned xcc = (unsigned)__builtin_amdgcn_s_getreg((3 << 11) | 20) & 0xFu;
    unsigned* census = ctrbase + 16;
    const unsigned rank = __hip_atomic_fetch_add(&census[xcc], 1u, __ATOMIC_RELAXED, __HIP_MEMORY_SCOPE_AGENT);
    for (;;) {
      unsigned sum = 0, npop = 0, pi = 0, mine = 0;
      for (unsigned j = 0; j < 16; ++j) {
        const unsigned v = __hip_atomic_load(&census[j], __ATOMIC_RELAXED, __HIP_MEMORY_SCOPE_AGENT);
        sum += v; npop += (v > 0u) ? 1u : 0u; pi += (v > 0u && j < xcc) ? 1u : 0u; mine = (j == xcc) ? v : mine;
      }
      if (sum == gridDim.x) { sx[0] = (int)pi; sx[1] = (int)npop; sx[2] = (int)rank; sx[3] = (int)mine; break; }
      __builtin_amdgcn_s_sleep(2);
    }
  }
  __syncthreads();
  XcdInfo X;
  X.pi = sx[0]; X.npop = sx[1]; X.rank = sx[2]; X.cnt = sx[3];
  __syncthreads();
  return X;
}
#define FOR_BATCH(b) for (int b = X.pi; b < 8; b += X.npop)
#define FOR_ITEMS(i, n) for (int i = X.rank; i < (n); i += X.cnt)

#ifndef PH
#define PH 0xFFF
#endif
#ifndef USE_CG
#define USE_CG 0
#endif
#ifndef DBL
#define DBL 0
#endif
#define PM(bit) (((DBL) & (bit)) ? 2 : 1)
__global__ void __launch_bounds__(256, 2) fwd_megakernel(Params p) {
  __shared__ __attribute__((aligned(16))) char smem[73728];
  cg::grid_group grid = cg::this_grid();
  const int nb = gridDim.x, bid = blockIdx.x, tid = threadIdx.x;
  unsigned* ctrs = (unsigned*)(p.ws + OFF_CTR);
  unsigned* bar = ctrs + 32;
  const XcdInfo X = xcd_setup(ctrs, smem);
  unsigned* xbar = ctrs + 64 + 32 * X.pi;

  {
    constexpr int N0 = 800, N1 = N0 + 256, N2 = N1 + 1024, N3 = N2 + 1024, N4 = N3 + 64, N5 = N4 + 64, N6 = N5 + 8, N7 = N6 + 8, N8 = N7 + 16;
    constexpr int NTOT = N8 + 65;
    for (int it0 = bid; it0 < NTOT * PM(8); it0 += nb) {
      const int it = it0 % NTOT;
      if (it < N0) { int i = it; transpose_tile(p.w_in, 3096, (u16*)(p.ws + OFF_WTIN), 1024, (i % 16) * 64, (i / 16) * 64, true, smem); }
      else if (it < N1) { int i = it - N0; transpose_tile(p.w_out, 1024, (u16*)(p.ws + OFF_WTOUT), 1024, (i % 16) * 64, (i / 16) * 64, false, smem); }
      else if (it < N2) { int i = it - N1; transpose_tile(p.w_ff1, 4096, (u16*)(p.ws + OFF_WTFF1), 1024, (i % 16) * 64, (i / 16) * 64, false, smem); }
      else if (it < N3) { int i = it - N2; transpose_tile(p.w_ff2, 1024, (u16*)(p.ws + OFF_WTFF2), 4096, (i % 64) * 64, (i / 64) * 64, false, smem); }
      else if (it < N4) { int i = it - N3; transpose_tile(p.ck_w1, 128, (u16*)(p.ws + OFF_CW1T), 2048, (i % 32) * 64, (i / 32) * 64, false, smem); }
      else if (it < N5) { int i = it - N4; transpose_tile(p.cv_w1, 128, (u16*)(p.ws + OFF_CW1T) + 128 * 2048, 2048, (i % 32) * 64, (i / 32) * 64, false, smem); }
      else if (it < N6) { int i = it - N5; transpose_tile(p.w2, 512, (u16*)(p.ws + OFF_W2T), 64, 0, i * 64, false, smem); }
      else if (it < N7) { int i = it - N6; transpose_tile(p.a2, 512, (u16*)(p.ws + OFF_A2T), 64, 0, i * 64, false, smem); }
      else if (it < N8) { int i = it - N7; transpose_tile(p.g2, 512, (u16*)(p.ws + OFF_G2T), 128, (i % 2) * 64, (i / 2) * 64, false, smem); }
      else if (it < N8 + 64) {
        const int idx = it - N8, kv = idx & 1, kc = idx >> 1;
        const float* pos = kv ? p.cv_pos : p.ck_pos;
        const float* w1 = kv ? p.cv_w1 : p.ck_w1;
        const int j = tid & 127, hh = tid >> 7;
        float a = 0.f;
#pragma unroll 8
        for (int k = kc * 64 + hh * 32; k < kc * 64 + hh * 32 + 32; ++k) a += pos[k] * w1[(size_t)k * 128 + j];
        float* s = (float*)smem;
        __syncthreads();
        s[tid] = a;
        __syncthreads();
        if (tid < 128) ((float*)(p.ws + OFF_PBP))[(kv * 32 + kc) * 128 + tid] = s[tid] + s[tid + 128];
        __syncthreads();
      } else {
        u16* kcn = (u16*)(p.ws + OFF_KCN);
        u16* vct = (u16*)(p.ws + OFF_VCT);
        for (int i = tid; i < 16 * 64; i += 256) {
          const int bh = i >> 6, d = i & 63;
          kcn[((size_t)bh * 256 + 255) * 64 + d] = 0;
          vct[((size_t)bh * 64 + d) * 256 + 255] = 0;
        }
      }
    }
    FOR_BATCH(b) FOR_ITEMS(i, 512) rmsnorm_rows(p.x, p.ln_mix_g, (u16*)(p.ws + OFF_BUFA), b * 512 + i);
  }
  asm volatile("s_waitcnt vmcnt(0)" ::: "memory");
  grid.sync();
  FOR_BATCH(b) FOR_ITEMS(i0, 400 * PM(32)) {
    const int i = i0 % 400;
    const int tng = i / 80, rem = i - tng * 80;
    gemm_tile<G_INPROJ, true>(p, b * 16 + rem / 5, tng * 5 + rem % 5, 0, smem);
  }
  xcd_barrier(xbar, (unsigned)X.cnt, 1u);
  {
    const int NS = X.cnt >= 32 ? 16 : (X.cnt >> 1);
    const int PS = X.cnt - NS, pr = X.rank - NS;
    unsigned* pbar = xbar + 2;
    unsigned kp = 0;
#pragma unroll 1
    for (int stage = 0; stage < 2; ++stage) {
      FOR_BATCH(b) {
        const bool mine = (stage == 0) || (pr >= 0);
        const int start = stage == 0 ? X.rank : pr, stride = stage == 0 ? X.cnt : PS, lo = stage * 32, hi = stage == 0 ? 32 : 128;
        if (mine) {
          for (int i = lo + start; i < hi; i += stride) gemm_tile<G_RWW>(p, b * 32 + (i >> 2), i & 3, 0, smem);
          for (int i = lo + start; i < hi; i += stride) gemm_tile<G_RWA>(p, b * 32 + (i >> 2), i & 3, 0, smem);
        }
        if (stage == 0) {
          for (int i = X.rank; i < 17; i += X.cnt) t0_item(p, b * 17 + i, smem);
        } else {
          ++kp;
          if (pr < 0) {
            for (int i = X.rank; i < 16; i += NS) scan_item(p, b, i >> 1, i & 1, smem, pbar + 1, kp);
            if (tid == 0) {
              while (__hip_atomic_load(pbar + 1, __ATOMIC_RELAXED, __HIP_MEMORY_SCOPE_AGENT) < kp) __builtin_amdgcn_s_sleep(2);
              __builtin_amdgcn_fence(__ATOMIC_ACQUIRE, "agent");
              asm volatile("s_waitcnt vmcnt(0)" ::: "memory");
            }
            __syncthreads();
          } else {
            const bool cpool = PS > 8;
            const int st = cpool ? PS - 8 : PS, me = cpool ? pr - 8 : pr;
            for (int i = pr; i < 8; i += PS) gemm_tile<G_CMP>(p, b * 4 + (i >> 1), 0, i & 1, smem);
            if (me >= 0) {
              for (int i = me; i < 256; i += st) vtrans_item(p, ((i >> 7) << 10) | (b << 7) | (i & 127), smem);
            }
            asm volatile("s_waitcnt vmcnt(0)" ::: "memory");
            __syncthreads();
            if (tid == 0) {
              __builtin_amdgcn_s_waitcnt(0);
              const unsigned old = __hip_atomic_fetch_add(pbar, 1u, __ATOMIC_RELAXED, __HIP_MEMORY_SCOPE_AGENT);
              if (old + 1u == (unsigned)PS * kp) __hip_atomic_fetch_add(pbar + 1, 1u, __ATOMIC_RELAXED, __HIP_MEMORY_SCOPE_AGENT);
              else while (__hip_atomic_load(pbar + 1, __ATOMIC_RELAXED, __HIP_MEMORY_SCOPE_AGENT) < kp) __builtin_amdgcn_s_sleep(1);
              __builtin_amdgcn_fence(__ATOMIC_ACQUIRE, "agent");
              asm volatile("s_waitcnt vmcnt(0)" ::: "memory");
            }
            __syncthreads();
          }
          int* sitem = (int*)(smem + 73728 - 16);
          while (true) {
            __syncthreads();
            if (tid == 0) *sitem = (int)atomicAdd(&ctrs[b], 1u);
            __syncthreads();
            const int item = *sitem;
            if (item >= 256 + 128) break;
            if (item < 256) attn_item(p, b, item, smem);
            else { const int i = item - 256; gemm_tile<G_RWG>(p, b * 32 + (i >> 2), i & 3, 0, smem); }
          }
        }
      }
      if (stage == 0) xcd_barrier(xbar, (unsigned)X.cnt, 2u);
    }
  }
  xcd_barrier(xbar, (unsigned)X.cnt, 3u);
  FOR_BATCH(b) FOR_ITEMS(i, 1024) gn_item(p, b, i);
  xcd_barrier(xbar, (unsigned)X.cnt, 4u);
  FOR_BATCH(b) FOR_ITEMS(i0, 128 * PM(64)) { const int i = i0 & 127; gemm_tile<G_OUT, true>(p, b * 16 + (i >> 3), i & 7, 0, smem); }
  xcd_barrier(xbar, (unsigned)X.cnt, 5u);
  FOR_BATCH(b) FOR_ITEMS(i, 512) rmsnorm_rows(p.out, p.ln_ffn_g, (u16*)(p.ws + OFF_BUFA), b * 512 + i);
  xcd_barrier(xbar, (unsigned)X.cnt, 6u);
  for (int rep = 0; rep < ((DBL & 1) ? 2 : 1); ++rep)
  FOR_BATCH(b) FOR_ITEMS(i, 512) {
    const int tnh = i >> 7, tm = (i >> 3) & 15, tnl = i & 7;
    gemm_tile<G_FF1, true>(p, b * 16 + tm, tnh * 8 + tnl, 0, smem);
  }
  xcd_barrier(xbar, (unsigned)X.cnt, 7u);
  FOR_BATCH(b) FOR_ITEMS(i, 128) gemm_tile<G_FF2, true>(p, b * 16 + (i >> 3), i & 7, 0, smem);
}

extern "C" void kernel_launch(void* const* d_in, const int* in_sizes, int n_in, void* d_out, int out_size, void* d_ws, size_t ws_size,
                              hipStream_t stream) {
  static int grid_blocks = 0;
  if (!grid_blocks) {
    int dev = 0, cus = 0, per_cu = 0;
    hipGetDevice(&dev);
    hipDeviceGetAttribute(&cus, hipDeviceAttributeMultiprocessorCount, dev);
    hipOccupancyMaxActiveBlocksPerMultiprocessor(&per_cu, fwd_megakernel, 256, 0);
    if (per_cu > 2) per_cu = 2;
    if (per_cu < 1) per_cu = 1;
    grid_blocks = cus * per_cu;
  }
  Params p{};
  const float** f = (const float**)&p;
  for (int i = 0; i < 29; ++i) f[i] = (const float*)d_in[i];
  p.out = (float*)d_out;
  p.ws = (char*)d_ws;
  hipMemsetAsync((char*)d_ws + OFF_CTR, 0, 4096, stream);
  void* args[] = {&p};
  hipError_t e = hipLaunchCooperativeKernel((void*)fwd_megakernel, dim3(grid_blocks), dim3(256), args, 0, stream);
  if (e != hipSuccess) fprintf(stderr, "cooperative launch failed: %s (grid %d)\n", hipGetErrorString(e), grid_blocks);
}
```

```cpp
#include <hip/hip_runtime.h>
#include <hip/hip_cooperative_groups.h>
#include <stdint.h>
#include <stdio.h>
namespace cg = cooperative_groups;

typedef __attribute__((ext_vector_type(8))) short bf16x8;
typedef __attribute__((ext_vector_type(4))) short s16x4;
typedef __attribute__((ext_vector_type(16))) float f32x16;
typedef __attribute__((ext_vector_type(2))) float f32x2;
typedef __attribute__((ext_vector_type(2))) _Float16 bfx2;
typedef __attribute__((ext_vector_type(8))) _Float16 h16x8;
typedef unsigned short u16;
#define DI __device__ __forceinline__
#define MFMA(a, b, c) __builtin_amdgcn_mfma_f32_32x32x16_f16(__builtin_bit_cast(h16x8, (a)), __builtin_bit_cast(h16x8, (b)), (c), 0, 0, 0)

constexpr int Bz = 8, T = 4096, M = Bz * T, NP = 3200;
constexpr int KC_OFF = 512, VC_OFF = 640, KS_OFF = 768, VS_OFF = 896, KW_OFF = 1024, VW_OFF = 1152,
              R_OFF = 1280, K_OFF = 1792, V_OFF = 2304, XW_OFF = 2816, XA_OFF = 2880, XG_OFF = 2944, GL_OFF = 3072;
constexpr int NCMP_ROWS = 8 * 255 * 2;

constexpr size_t OFF_WTIN = 0;
constexpr size_t OFF_WTOUT = OFF_WTIN + (size_t)3200 * 1024 * 2;
constexpr size_t OFF_WTFF1 = OFF_WTOUT + (size_t)1024 * 1024 * 2;
constexpr size_t OFF_WTFF2 = OFF_WTFF1 + (size_t)4096 * 1024 * 2;
constexpr size_t OFF_CW1T = OFF_WTFF2 + (size_t)4096 * 1024 * 2;
constexpr size_t OFF_W2T = OFF_CW1T + (size_t)2 * 128 * 2048 * 2;
constexpr size_t OFF_A2T = OFF_W2T + (size_t)512 * 64 * 2;
constexpr size_t OFF_G2T = OFF_A2T + (size_t)512 * 64 * 2;
constexpr size_t OFF_PBIAS = OFF_G2T + (size_t)512 * 128 * 2;
constexpr size_t OFF_CTR = OFF_PBIAS + 1024;
constexpr size_t OFF_KCN = OFF_CTR + 4096;
constexpr size_t OFF_VCT = OFF_KCN + (size_t)8 * 2 * 256 * 64 * 2;
constexpr size_t OFF_VST = OFF_VCT + (size_t)8 * 2 * 256 * 64 * 2;
constexpr size_t OFF_VWT = OFF_VST + (size_t)8 * 2 * 64 * 4096 * 2;
constexpr size_t OFF_BUFA = OFF_VWT + (size_t)8 * 2 * 64 * 4096 * 2;
constexpr size_t OFF_PROJ = OFF_BUFA + (size_t)M * 1024 * 2;
constexpr size_t OFF_AA = OFF_PROJ + (size_t)M * NP * 2;
constexpr size_t OFF_MIX = OFF_AA + (size_t)M * 512 * 4;
constexpr size_t OFF_G = OFF_MIX + (size_t)M * 1024 * 2;
constexpr size_t OFF_T0 = OFF_G + (size_t)M * 512 * 2;
constexpr size_t OFF_PBP = OFF_T0 + 65536;
constexpr size_t OFF_BON = OFF_PBP + 65536;

struct Params {
  const float *x, *ln_mix_g, *w_in, *gate_b, *q_g, *kc_g, *ks_g, *kw_g;
  const float *ck_pos, *ck_w1, *ck_w2, *cv_pos, *cv_w1, *cv_w2;
  const float *mu, *w0, *w2, *a0, *a2, *g2, *k_k, *k_a, *r_k, *lnx_w, *lnx_b;
  const float *w_out, *ln_ffn_g, *w_ff1, *w_ff2;
  float* out;
  char* ws;
};

DI int launder(int x) { asm volatile("" : "+v"(x)); return x; }
DI float bf2f(u16 h) { return (float)__builtin_bit_cast(_Float16, h); }
DI unsigned pack2(float a, float b) { f32x2 v = {a, b}; bfx2 r = __builtin_convertvector(v, bfx2); return __builtin_bit_cast(unsigned, r); }
DI u16 f2bf(float a) { return (u16)(pack2(a, 0.f) & 0xffffu); }
DI float lo_bf(unsigned u) { bfx2 h = __builtin_bit_cast(bfx2, u); return (float)h[0]; }
DI float hi_bf(unsigned u) { bfx2 h = __builtin_bit_cast(bfx2, u); return (float)h[1]; }
DI float sigmoidf_(float x) { return 1.f / (1.f + __expf(-x)); }
DI float wave_sum(float v) {
  v += __shfl_xor(v, 32); v += __shfl_xor(v, 16); v += __shfl_xor(v, 8);
  v += __shfl_xor(v, 4); v += __shfl_xor(v, 2); v += __shfl_xor(v, 1);
  return v;
}
template <int CTRL> DI float dpp_f(float v) {
  return __builtin_bit_cast(float, __builtin_amdgcn_update_dpp(0, __builtin_bit_cast(int, v), CTRL, 0xF, 0xF, false));
}
DI float oct_sum(float v) { v += dpp_f<0xB1>(v); v += dpp_f<0x4E>(v); v += dpp_f<0x141>(v); return v; }
DI float quad_sum(float v) { v += dpp_f<0xB1>(v); v += dpp_f<0x4E>(v); return v; }
DI float row16_sum(float v) { v += dpp_f<0x128>(v); v += dpp_f<0x124>(v); v += dpp_f<0x122>(v); v += dpp_f<0x121>(v); return v; }

constexpr size_t PROJ_B = (size_t)T * NP * 2, AA_B = (size_t)T * 512 * 4, SLAB = PROJ_B + AA_B;
static_assert((size_t)T * 4096 * 2 <= SLAB, "hidden must fit its batch slab");
DI size_t prow(size_t m) { return m * NP + (m >> 12) * (AA_B / 2); }
DI float* aaptr(char* ws, size_t m) { return (float*)(ws + OFF_PROJ + (m >> 12) * SLAB + PROJ_B) + (m & 4095) * 512; }
DI size_t hid_off(int m, int c) { const int ml = m & 4095; return (size_t)(m >> 12) * (SLAB / 2) + ((size_t)((ml >> 8) * 128 + (c >> 5)) << 13) + (size_t)((ml & 255) * 32 + (c & 31)); }
DI int map_win(int nd) { return nd < 1280 ? nd : (nd < 3072 ? nd + 24 : (nd < 3096 ? nd - 3072 + 1280 : -1)); }

DI void transpose_tile(const float* __restrict__ src, int ldsrc, u16* __restrict__ dst, int Kd, int k0, int n0, bool mapped, char* smem) {
  float* s = (float*)smem;
  const int tid = threadIdx.x;
  __syncthreads();
  const int nn = tid & 63;
  const int nd = n0 + nn;
  const int sc = mapped ? map_win(nd) : nd;
#pragma unroll 4
  for (int i = 0; i < 16; ++i) {
    int k = (tid >> 6) + 4 * i;
    float v = (sc >= 0) ? src[(size_t)(k0 + k) * ldsrc + sc] : 0.f;
    s[k * 65 + nn] = v;
  }
  __syncthreads();
  const int n = tid >> 2, kc = (tid & 3) * 16;
  unsigned pk[8];
#pragma unroll
  for (int e = 0; e < 8; ++e) pk[e] = pack2(s[(kc + 2 * e) * 65 + n], s[(kc + 2 * e + 1) * 65 + n]);
  uint4* d = (uint4*)(dst + (size_t)(n0 + n) * Kd + k0 + kc);
  d[0] = make_uint4(pk[0], pk[1], pk[2], pk[3]);
  d[1] = make_uint4(pk[4], pk[5], pk[6], pk[7]);
  __syncthreads();
}

DI void rmsnorm_rows(const float* __restrict__ src, const float* __restrict__ g, u16* __restrict__ dst, int item) {
  const int lane = threadIdx.x & 63, w = threadIdx.x >> 6;
  const size_t row = (size_t)item * 4 + w;
  const float4* s4 = (const float4*)(src + row * 1024);
  float4 v[4];
  float ss = 0.f;
#pragma unroll
  for (int i = 0; i < 4; ++i) { v[i] = s4[lane + 64 * i]; ss += v[i].x * v[i].x + v[i].y * v[i].y + v[i].z * v[i].z + v[i].w * v[i].w; }
  ss = wave_sum(ss);
  const float sc = rsqrtf(ss * (1.f / 1024.f) + 1e-6f);
  const float4* g4 = (const float4*)g;
#pragma unroll
  for (int i = 0; i < 4; ++i) {
    float4 gg = g4[lane + 64 * i];
    uint2 o = make_uint2(pack2(v[i].x * sc * gg.x, v[i].y * sc * gg.y), pack2(v[i].z * sc * gg.z, v[i].w * sc * gg.w));
    *(uint2*)(dst + row * 1024 + (lane + 64 * i) * 4) = o;
  }
}

enum { G_INPROJ = 0, G_CMP, G_RWG, G_RWW, G_RWA, G_OUT, G_FF1, G_FF2 };

template <int MODE> DI constexpr int gemm_kt() {
  return MODE == G_INPROJ ? 16 : MODE == G_CMP ? 32 : MODE == G_RWG ? 2 : MODE == G_RWW ? 1 : MODE == G_RWA ? 1 : MODE == G_OUT ? 16 : MODE == G_FF1 ? 16 : 64;
}

template <int MODE> DI uint4 load_a(const Params& p, int tm, int kv, int row, int kt, int c) {
  const u16* proj = (const u16*)(p.ws + OFF_PROJ);
  if constexpr (MODE == G_INPROJ || MODE == G_FF1) {
    const u16* A = (const u16*)(p.ws + OFF_BUFA);
    return *(const uint4*)(A + (size_t)(tm * 128 + row) * 1024 + kt * 64 + c * 8);
  } else if constexpr (MODE == G_OUT) {
    const u16* A = (const u16*)(p.ws + OFF_MIX);
    return *(const uint4*)(A + (size_t)(tm * 128 + row) * 1024 + kt * 64 + c * 8);
  } else if constexpr (MODE == G_FF2) {
    const u16* A = (const u16*)(p.ws + OFF_PROJ);
    return *(const uint4*)(A + hid_off(tm * 128 + row, kt * 64 + c * 8));
  } else if constexpr (MODE == G_CMP) {
    const int b = tm >> 2; int rem = (tm & 3) * 128 + row; rem = rem < 510 ? rem : 509;
    const int i = rem >> 1, h = rem & 1;
    return *(const uint4*)(proj + prow((size_t)(b * T + 16 * i + kt)) + (kv ? VC_OFF : KC_OFF) + h * 64 + c * 8);
  } else {
    constexpr int OFFX = MODE == G_RWG ? XG_OFF : MODE == G_RWW ? XW_OFF : XA_OFF;
    const int m = tm * 128 + row;
    const int col = OFFX + kt * 64 + c * 8;
    const uint4 cur = *(const uint4*)(proj + prow(m) + col);
    uint4 prv = make_uint4(0, 0, 0, 0);
    if ((m & (T - 1)) != 0) prv = *(const uint4*)(proj + prow(m - 1) + col);
    const float4* mu4 = (const float4*)(p.mu + (col - 1280));
    const float4 m0 = mu4[0], m1 = mu4[1];
    const unsigned cu[4] = {cur.x, cur.y, cur.z, cur.w}, pu[4] = {prv.x, prv.y, prv.z, prv.w};
    const float mm[8] = {m0.x, m0.y, m0.z, m0.w, m1.x, m1.y, m1.z, m1.w};
    unsigned o[4];
#pragma unroll
    for (int e = 0; e < 4; ++e) {
      float c0 = lo_bf(cu[e]), c1 = hi_bf(cu[e]), p0 = lo_bf(pu[e]), p1 = hi_bf(pu[e]);
      float z0 = c0 + (p0 - c0) * mm[2 * e], z1 = c1 + (p1 - c1) * mm[2 * e + 1];
      if constexpr (MODE == G_RWG) { z0 = sigmoidf_(z0); z1 = sigmoidf_(z1); }
      if constexpr (MODE == G_RWW) { z0 = tanhf(z0); z1 = tanhf(z1); }
      o[e] = pack2(z0, z1);
    }
    return make_uint4(o[0], o[1], o[2], o[3]);
  }
}

template <int MODE> DI uint4 load_b(const Params& p, int tn, int kv, int row, int kt, int c) {
  if constexpr (MODE == G_INPROJ) return *(const uint4*)((const u16*)(p.ws + OFF_WTIN) + (size_t)(tn * 128 + row) * 1024 + kt * 64 + c * 8);
  else if constexpr (MODE == G_OUT) return *(const uint4*)((const u16*)(p.ws + OFF_WTOUT) + (size_t)(tn * 128 + row) * 1024 + kt * 64 + c * 8);
  else if constexpr (MODE == G_FF1) return *(const uint4*)((const u16*)(p.ws + OFF_WTFF1) + (size_t)(tn * 128 + row) * 1024 + kt * 64 + c * 8);
  else if constexpr (MODE == G_FF2) return *(const uint4*)((const u16*)(p.ws + OFF_WTFF2) + (size_t)(tn * 128 + row) * 4096 + kt * 64 + c * 8);
  else if constexpr (MODE == G_CMP) return *(const uint4*)((const u16*)(p.ws + OFF_CW1T) + (size_t)(kv * 128 + row) * 2048 + kt * 64 + c * 8);
  else if constexpr (MODE == G_RWG) return *(const uint4*)((const u16*)(p.ws + OFF_G2T) + (size_t)(tn * 128 + row) * 128 + kt * 64 + c * 8);
  else if constexpr (MODE == G_RWW) return *(const uint4*)((const u16*)(p.ws + OFF_W2T) + (size_t)(tn * 128 + row) * 64 + c * 8);
  else return *(const uint4*)((const u16*)(p.ws + OFF_A2T) + (size_t)(tn * 128 + row) * 64 + c * 8);
}

DI float gelu_tanh(float x) {
  const float u = 0.7978845608028654f * (x + 0.044715f * x * x * x);
  return 0.5f * x * (1.f + tanhf(u));
}

template <int MODE, bool BIG = false> DI void gemm_tile(const Params& p, int tm, int tn, int kv, char* smem) {
  constexpr int KT = gemm_kt<MODE>();
  constexpr int RB = BIG ? 256 : 128;
  constexpr int MT = BIG ? 4 : 2;
  const int tid = launder(threadIdx.x), lane = tid & 63, w = tid >> 6;
  const int r = lane & 31, hf = lane >> 5;
  const int wm = w >> 1, wn = w & 1;
  char* As = smem;
  char* Bs = smem + 128 * 144;
  float* Cs = (float*)smem;
  const int tma = BIG ? tm * 2 : tm;

  f32x16 acc[MT][2];
#pragma unroll
  for (int i = 0; i < MT; ++i)
#pragma unroll
    for (int j = 0; j < 2; ++j)
#pragma unroll
      for (int e = 0; e < 16; ++e) acc[i][j][e] = 0.f;

  if constexpr (!BIG) {
    uint4 ra[4], rb[4];
#pragma unroll
    for (int i = 0; i < 4; ++i) { const int id = tid + 256 * i; ra[i] = load_a<MODE>(p, tma, kv, id >> 3, 0, id & 7); rb[i] = load_b<MODE>(p, tn, kv, id >> 3, 0, id & 7); }
    for (int kt = 0; kt < KT; ++kt) {
      __syncthreads();
#pragma unroll
      for (int i = 0; i < 4; ++i) {
        const int id = tid + 256 * i;
        *(uint4*)(As + (id >> 3) * 144 + (id & 7) * 16) = ra[i];
        *(uint4*)(Bs + (id >> 3) * 144 + (id & 7) * 16) = rb[i];
      }
      __syncthreads();
      if (kt + 1 < KT) {
#pragma unroll
        for (int i = 0; i < 4; ++i) { const int id = tid + 256 * i; ra[i] = load_a<MODE>(p, tma, kv, id >> 3, kt + 1, id & 7); rb[i] = load_b<MODE>(p, tn, kv, id >> 3, kt + 1, id & 7); }
      }
#pragma unroll
      for (int s = 0; s < 4; ++s) {
        bf16x8 af[2], bfr[2];
#pragma unroll
        for (int i = 0; i < 2; ++i) af[i] = *(const bf16x8*)(As + (wm * 64 + i * 32 + r) * 144 + s * 32 + hf * 16);
#pragma unroll
        for (int j = 0; j < 2; ++j) bfr[j] = *(const bf16x8*)(Bs + (wn * 64 + j * 32 + r) * 144 + s * 32 + hf * 16);
#pragma unroll
        for (int i = 0; i < 2; ++i)
#pragma unroll
          for (int j = 0; j < 2; ++j) acc[i][j] = MFMA(af[i], bfr[j], acc[i][j]);
      }
    }
  } else {
    char* Bs2 = smem + 256 * 80;
    uint4 ra[4], rb[2];
#pragma unroll
    for (int i = 0; i < 4; ++i) { const int id = tid + 256 * i; ra[i] = load_a<MODE>(p, tma, kv, id >> 2, 0, id & 3); }
#pragma unroll
    for (int i = 0; i < 2; ++i) { const int id = tid + 256 * i; rb[i] = load_b<MODE>(p, tn, kv, id >> 2, 0, id & 3); }
    for (int kt = 0; kt < 2 * KT; ++kt) {
      __syncthreads();
#pragma unroll
      for (int i = 0; i < 4; ++i) { const int id = tid + 256 * i; *(uint4*)(As + (id >> 2) * 80 + (id & 3) * 16) = ra[i]; }
#pragma unroll
      for (int i = 0; i < 2; ++i) { const int id = tid + 256 * i; *(uint4*)(Bs2 + (id >> 2) * 80 + (id & 3) * 16) = rb[i]; }
      __syncthreads();
      if (kt + 1 < 2 * KT) {
        const int k1 = kt + 1;
#pragma unroll
        for (int i = 0; i < 4; ++i) { const int id = tid + 256 * i; ra[i] = load_a<MODE>(p, tma, kv, id >> 2, k1 >> 1, ((k1 & 1) << 2) | (id & 3)); }
#pragma unroll
        for (int i = 0; i < 2; ++i) { const int id = tid + 256 * i; rb[i] = load_b<MODE>(p, tn, kv, id >> 2, k1 >> 1, ((k1 & 1) << 2) | (id & 3)); }
      }
      {
        bf16x8 af[2][4], bfr[2][2];
#pragma unroll
        for (int s = 0; s < 2; ++s) {
#pragma unroll
          for (int i = 0; i < 4; ++i) af[s][i] = *(const bf16x8*)(As + (wm * 128 + i * 32 + r) * 80 + s * 32 + hf * 16);
#pragma unroll
          for (int j = 0; j < 2; ++j) bfr[s][j] = *(const bf16x8*)(Bs2 + (wn * 64 + j * 32 + r) * 80 + s * 32 + hf * 16);
        }
        __builtin_amdgcn_s_setprio(1);
#pragma unroll
        for (int s = 0; s < 2; ++s)
#pragma unroll
          for (int i = 0; i < 4; ++i)
#pragma unroll
            for (int j = 0; j < 2; ++j) acc[i][j] = MFMA(af[s][i], bfr[s][j], acc[i][j]);
        __builtin_amdgcn_s_setprio(0);
      }
    }
  }
#pragma unroll 1
  for (int hh = 0; hh < (BIG ? 2 : 1); ++hh) {
  __syncthreads();
  if (!BIG || wm == hh) {
#pragma unroll
    for (int i = 0; i < MT; ++i)
#pragma unroll
      for (int j = 0; j < 2; ++j)
#pragma unroll
        for (int e = 0; e < 16; ++e) {
          const int row = (BIG ? 0 : wm * 64) + i * 32 + 8 * (e >> 2) + 4 * hf + (e & 3);
          const int col = wn * 64 + j * 32 + r;
          Cs[row * 132 + col] = acc[i][j][e];
        }
  }
  __syncthreads();

  const int row = tid >> 1, half = tid & 1;
  float* crow = Cs + row * 132 + half * 64;
  const float4* crow4 = (const float4*)crow;
  const int m = tm * RB + hh * 128 + row;
  const int col0 = tn * 128 + half * 64;

  if constexpr (MODE == G_INPROJ) {
    u16* proj = (u16*)(p.ws + OFF_PROJ);
    const int region = col0 >> 6;
    const float* g = nullptr; float extra = 1.f;
    if (region < 8) { g = p.q_g; extra = 0.125f; }
    else if (region == 12 || region == 13) g = p.ks_g;
    else if (region == 16 || region == 17) g = p.kw_g;
    float sc = 1.f;
    if (g) {
      float ss = 0.f;
#pragma unroll
      for (int c4 = 0; c4 < 16; ++c4) { float4 v = crow4[c4]; ss += v.x * v.x + v.y * v.y + v.z * v.z + v.w * v.w; }
      sc = rsqrtf(ss * (1.f / 64.f) + 1e-6f) * extra;
    }
#pragma unroll
    for (int c8 = 0; c8 < 8; ++c8) {
      float4 v0 = crow4[2 * c8], v1 = crow4[2 * c8 + 1];
      float v[8] = {v0.x, v0.y, v0.z, v0.w, v1.x, v1.y, v1.z, v1.w};
      if (g) {
#pragma unroll
        for (int e = 0; e < 8; ++e) v[e] = v[e] * sc * g[c8 * 8 + e];
      } else if (region == 48) {
#pragma unroll
        for (int e = 0; e < 8; ++e) { int c = c8 * 8 + e; v[e] = c < 24 ? sigmoidf_(v[e] + p.gate_b[c]) : 0.f; }
      }
      *(uint4*)(proj + prow(m) + col0 + c8 * 8) = make_uint4(pack2(v[0], v[1]), pack2(v[2], v[3]), pack2(v[4], v[5]), pack2(v[6], v[7]));
    }
  } else if constexpr (MODE == G_OUT) {
    const float4* x4 = (const float4*)(p.x + (size_t)m * 1024 + col0);
    float4* o4 = (float4*)(p.out + (size_t)m * 1024 + col0);
#pragma unroll
    for (int c4 = 0; c4 < 16; ++c4) { float4 v = crow4[c4], xx = x4[c4]; o4[c4] = make_float4(v.x + xx.x, v.y + xx.y, v.z + xx.z, v.w + xx.w); }
  } else if constexpr (MODE == G_FF2) {
    float4* o4 = (float4*)(p.out + (size_t)m * 1024 + col0);
#pragma unroll
    for (int c4 = 0; c4 < 16; ++c4) { float4 v = crow4[c4], xx = o4[c4]; o4[c4] = make_float4(v.x + xx.x, v.y + xx.y, v.z + xx.z, v.w + xx.w); }
  } else if constexpr (MODE == G_FF1) {
    u16* hid = (u16*)(p.ws + OFF_PROJ);
#pragma unroll
    for (int c8 = 0; c8 < 8; ++c8) {
      float4 v0 = crow4[2 * c8], v1 = crow4[2 * c8 + 1];
      float v[8] = {v0.x, v0.y, v0.z, v0.w, v1.x, v1.y, v1.z, v1.w};
#pragma unroll
      for (int e = 0; e < 8; ++e) { float t = fmaxf(v[e], 0.f); v[e] = t * t; }
      *(uint4*)(hid + hid_off(m, col0 + c8 * 8)) = make_uint4(pack2(v[0], v[1]), pack2(v[2], v[3]), pack2(v[4], v[5]), pack2(v[6], v[7]));
    }
  } else if constexpr (MODE == G_RWG) {
    u16* gb = (u16*)(p.ws + OFF_G);
#pragma unroll
    for (int c8 = 0; c8 < 8; ++c8) {
      float4 v0 = crow4[2 * c8], v1 = crow4[2 * c8 + 1];
      *(uint4*)(gb + (size_t)m * 512 + col0 + c8 * 8) = make_uint4(pack2(v0.x, v0.y), pack2(v0.z, v0.w), pack2(v1.x, v1.y), pack2(v1.z, v1.w));
    }
  } else if constexpr (MODE == G_RWW) {
    float4* W4 = (float4*)((float*)(p.ws + OFF_BUFA) + (size_t)m * 512 + col0);
    const float4* w04 = (const float4*)(p.w0 + col0);
#pragma unroll
    for (int c4 = 0; c4 < 16; ++c4) {
      float4 v = crow4[c4], ww = w04[c4];
      float u[4] = {v.x + ww.x, v.y + ww.y, v.z + ww.z, v.w + ww.w};
#pragma unroll
      for (int e = 0; e < 4; ++e) {
        const float z = -u[e];
        const float sp = fmaxf(z, 0.f) + log1pf(__expf(-fabsf(z)));
        u[e] = __expf(-__expf(-sp - 0.5f));
      }
      W4[c4] = make_float4(u[0], u[1], u[2], u[3]);
    }
  } else if constexpr (MODE == G_RWA) {
    const u16* proj = (const u16*)(p.ws + OFF_PROJ);
    float* prm = (float*)(smem + 128 * 132 * 4);
    if (tid < 128) {
      const int c = tn * 128 + tid;
      prm[tid] = p.mu[512 + c]; prm[128 + tid] = p.k_k[c]; prm[256 + tid] = p.a0[c]; prm[384 + tid] = p.k_a[c];
    }
    __syncthreads();
    const float* pmu = prm + half * 64; const float* pkk = prm + 128 + half * 64;
    const float* pa0 = prm + 256 + half * 64; const float* pka = prm + 384 + half * 64;
    float* AA = aaptr(p.ws, m) + col0;
    float* KP = p.out + (size_t)(m >> 12) * (4096 * 1024) + (size_t)(m & 4095) * 512 + col0;
    float* KK = KP + (size_t)4096 * 512;
    const bool has_prev = (m & (T - 1)) != 0;
    const u16* pc = proj + prow(m) + K_OFF + col0;
    const u16* pp = proj + prow(m - 1) + K_OFF + col0;
    float ss = 0.f;
#pragma unroll 2
    for (int c8 = 0; c8 < 8; ++c8) {
      uint4 cu = *(const uint4*)(pc + c8 * 8);
      uint4 pu = has_prev ? *(const uint4*)(pp + c8 * 8) : make_uint4(0, 0, 0, 0);
      const unsigned cw[4] = {cu.x, cu.y, cu.z, cu.w}, pw[4] = {pu.x, pu.y, pu.z, pu.w};
#pragma unroll
      for (int e = 0; e < 8; ++e) {
        const int c = c8 * 8 + e;
        const float cc = (e & 1) ? hi_bf(cw[e >> 1]) : lo_bf(cw[e >> 1]);
        const float pv = (e & 1) ? hi_bf(pw[e >> 1]) : lo_bf(pw[e >> 1]);
        const float k = cc + (pv - cc) * pmu[c];
        const float kkv = k * pkk[c];
        ss += kkv * kkv;
      }
    }
    const float inv = rsqrtf(fmaxf(ss, 1e-24f));
#pragma unroll 2
    for (int c8 = 0; c8 < 8; ++c8) {
      uint4 cu = *(const uint4*)(pc + c8 * 8);
      uint4 pu = has_prev ? *(const uint4*)(pp + c8 * 8) : make_uint4(0, 0, 0, 0);
      const unsigned cw[4] = {cu.x, cu.y, cu.z, cu.w}, pw[4] = {pu.x, pu.y, pu.z, pu.w};
      float4 v0 = crow4[2 * c8], v1 = crow4[2 * c8 + 1];
      const float av[8] = {v0.x, v0.y, v0.z, v0.w, v1.x, v1.y, v1.z, v1.w};
      float ao[8], kpo[8], kko[8];
#pragma unroll
      for (int e = 0; e < 8; ++e) {
        const int c = c8 * 8 + e;
        const float cc = (e & 1) ? hi_bf(cw[e >> 1]) : lo_bf(cw[e >> 1]);
        const float pv = (e & 1) ? hi_bf(pw[e >> 1]) : lo_bf(pw[e >> 1]);
        const float k = cc + (pv - cc) * pmu[c];
        const float a = sigmoidf_(pa0[c] + av[e]);
        ao[e] = a;
        kko[e] = k * pkk[c] * inv;
        kpo[e] = k * (1.f + (a - 1.f) * pka[c]);
      }
      *(float4*)(AA + c8 * 8) = make_float4(ao[0], ao[1], ao[2], ao[3]);
      *(float4*)(AA + c8 * 8 + 4) = make_float4(ao[4], ao[5], ao[6], ao[7]);
      *(float4*)(KP + c8 * 8) = make_float4(kpo[0], kpo[1], kpo[2], kpo[3]);
      *(float4*)(KP + c8 * 8 + 4) = make_float4(kpo[4], kpo[5], kpo[6], kpo[7]);
      *(float4*)(KK + c8 * 8) = make_float4(kko[0], kko[1], kko[2], kko[3]);
      *(float4*)(KK + c8 * 8 + 4) = make_float4(kko[4], kko[5], kko[6], kko[7]);
    }
  } else if constexpr (MODE == G_CMP) {
    float* pbl = (float*)(smem + 128 * 132 * 4);
    if (tid < 128) {
      const float* pp = (const float*)(p.ws + OFF_PBP) + kv * 32 * 128 + tid;
      float a = 0.f;
#pragma unroll 8
      for (int c = 0; c < 32; ++c) a += pp[c * 128];
      pbl[tid] = a;
    }
    __syncthreads();
    const float* pb = pbl + half * 64;
#pragma unroll
    for (int c4 = 0; c4 < 16; ++c4) {
      float4 v = crow4[c4];
      v.x = gelu_tanh(v.x + pb[c4 * 4 + 0]); v.y = gelu_tanh(v.y + pb[c4 * 4 + 1]);
      v.z = gelu_tanh(v.z + pb[c4 * 4 + 2]); v.w = gelu_tanh(v.w + pb[c4 * 4 + 3]);
      ((float4*)crow)[c4] = v;
    }
    __syncthreads();
    const float* w2 = kv ? p.cv_w2 : p.ck_w2;
    float w2c[64];
#pragma unroll
    for (int j = 0; j < 64; ++j) w2c[j] = w2[j * 64 + lane];
    for (int rr = 0; rr < 32; ++rr) {
      const int lrow = w * 32 + rr;
      const float4* h4 = (const float4*)(Cs + lrow * 132);
      float a = 0.f;
#pragma unroll
      for (int j4 = 0; j4 < 16; ++j4) {
        float4 hv = h4[j4];
        a += hv.x * w2c[4 * j4] + hv.y * w2c[4 * j4 + 1] + hv.z * w2c[4 * j4 + 2] + hv.w * w2c[4 * j4 + 3];
      }
      Cs[lrow * 132 + lane] = a;
    }
#pragma unroll
    for (int j = 0; j < 64; ++j) w2c[j] = w2[(64 + j) * 64 + lane];
    const float gk = p.kc_g[lane];
    u16* kcn = (u16*)(p.ws + OFF_KCN);
    u16* vct = (u16*)(p.ws + OFF_VCT);
    for (int rr = 0; rr < 32; ++rr) {
      const int lrow = w * 32 + rr;
      const float4* h4 = (const float4*)(Cs + lrow * 132 + 64);
      float a = Cs[lrow * 132 + lane];
#pragma unroll
      for (int j4 = 0; j4 < 16; ++j4) {
        float4 hv = h4[j4];
        a += hv.x * w2c[4 * j4] + hv.y * w2c[4 * j4 + 1] + hv.z * w2c[4 * j4 + 2] + hv.w * w2c[4 * j4 + 3];
      }
      const int rem = (tm & 3) * 128 + lrow;
      const float ss = wave_sum(a * a);
      if (rem < 510) {
        const int b = tm >> 2; const int i = rem >> 1, h = rem & 1;
        if (kv == 0) kcn[((size_t)(b * 2 + h) * 256 + i) * 64 + lane] = f2bf(a * rsqrtf(ss * (1.f / 64.f) + 1e-6f) * gk);
        else vct[((size_t)(b * 2 + h) * 64 + lane) * 256 + i] = f2bf(a);
      }
    }
  }
  }
}

DI void vtrans_item(const Params& p, int item, char* smem) {
  const int tb = item & 63, h = (item >> 6) & 1, b = (item >> 7) & 7, which = item >> 10;
  const u16* proj = (const u16*)(p.ws + OFF_PROJ);
  u16* dst = (u16*)(p.ws + (which ? OFF_VWT : OFF_VST)) + (size_t)(b * 2 + h) * 64 * T;
  const int off = (which ? VW_OFF : VS_OFF) + h * 64;
  u16* s = (u16*)smem;
  const int tid = threadIdx.x;
  __syncthreads();
#pragma unroll
  for (int i = 0; i < 2; ++i) {
    const int id = tid + 256 * i; const int t = id >> 3, c = id & 7;
    uint4 v = *(const uint4*)(proj + prow((size_t)(b * T + tb * 64 + t)) + off + c * 8);
    unsigned* sp = (unsigned*)(s + t * 66 + c * 8);
    sp[0] = v.x; sp[1] = v.y; sp[2] = v.z; sp[3] = v.w;
  }
  __syncthreads();
  const int d = tid >> 2, tc = (tid & 3) * 16;
  unsigned pk[8];
#pragma unroll
  for (int e = 0; e < 8; ++e) pk[e] = (unsigned)s[(tc + 2 * e) * 66 + d] | ((unsigned)s[(tc + 2 * e + 1) * 66 + d] << 16);
  uint4* o = (uint4*)(dst + (size_t)d * T + tb * 64 + tc);
  o[0] = make_uint4(pk[0], pk[1], pk[2], pk[3]);
  o[1] = make_uint4(pk[4], pk[5], pk[6], pk[7]);
  __syncthreads();
}

constexpr float L2E = 1.4426950408889634f;
constexpr float NEGB = -1e30f;
constexpr int A_KS = 0;
constexpr int A_VT = 64 * 144;
constexpr int A_IMP = 2 * 64 * 144;
constexpr int A_SEL = A_IMP + 32 * 68 * 4;
constexpr int A_JL = A_SEL + 32 * 8 + 16;
constexpr int A_OUT = A_JL + 64;
constexpr int A_END = A_OUT + 4 * 32 * 144;
static_assert(A_END <= 73728 - 16, "lds");

struct TileRegs { uint4 k0, k1, v0, v1; };
DI TileRegs tile_issue(const u16* kp, size_t kld, const u16* vp, size_t vld) {
  const int tid = launder(threadIdx.x);
  TileRegs tr;
  tr.k0 = *(const uint4*)(kp + (size_t)(tid >> 3) * kld + (tid & 7) * 8);
  tr.k1 = *(const uint4*)(kp + (size_t)((tid >> 3) + 32) * kld + (tid & 7) * 8);
  tr.v0 = *(const uint4*)(vp + (size_t)(tid >> 3) * vld + (tid & 7) * 8);
  tr.v1 = *(const uint4*)(vp + (size_t)((tid >> 3) + 32) * vld + (tid & 7) * 8);
  return tr;
}
DI void tile_commit(const TileRegs tr, char* smem) {
  const int tid = launder(threadIdx.x);
  *(uint4*)(smem + A_KS + (tid >> 3) * 144 + (tid & 7) * 16) = tr.k0;
  *(uint4*)(smem + A_KS + ((tid >> 3) + 32) * 144 + (tid & 7) * 16) = tr.k1;
  *(uint4*)(smem + A_VT + (tid >> 3) * 144 + (tid & 7) * 16) = tr.v0;
  *(uint4*)(smem + A_VT + ((tid >> 3) + 32) * 144 + (tid & 7) * 16) = tr.v1;
}

template <class PF, class CF> DI void run_tiles(char* smem, int n, PF issue_i, CF comp) {
  TileRegs ta = issue_i(0);
  TileRegs tb = issue_i(n > 1 ? 1 : 0);
  for (int i = 0; i < n; i += 2) {
    __syncthreads();
    tile_commit(ta, smem);
    __syncthreads();
    if (i + 2 < n) ta = issue_i(i + 2);
    comp(i);
    if (i + 1 >= n) break;
    __syncthreads();
    tile_commit(tb, smem);
    __syncthreads();
    if (i + 3 < n) tb = issue_i(i + 3);
    comp(i + 1);
  }
}

DI constexpr int kappa(int it, int e) { return it * 32 + 8 * (e >> 2) + (e & 3); }

struct BiasC { float sq1, sq2, sq3, sg[8]; };
DI float sgpr_f(float x) { return __int_as_float(__builtin_amdgcn_readfirstlane(__float_as_int(x))); }
DI float pow2_scale(float c, int k) { return c == 0.f ? 0.f : __int_as_float(__float_as_int(c) - (k << 23)); }
template <int KS> DI BiasC make_bias(int k) {
  BiasC c;
  c.sq1 = pow2_scale((float)KS, k); c.sq2 = pow2_scale(2.f * KS, k); c.sq3 = pow2_scale(3.f * KS, k);
#pragma unroll
  for (int i = 0; i < 8; ++i) c.sg[i] = pow2_scale((float)(KS * (32 * (i >> 2) + 8 * (i & 3))), k);
  return c;
}
DI void qk_scores(const char* Ks, const bf16x8 (&qf)[4], f32x16 (&S)[2], float bbase, const BiasC& bc, int lane) {
  lane = launder(lane);
  const int r = lane & 31, hf = lane >> 5;
#pragma unroll
  for (int it = 0; it < 2; ++it)
#pragma unroll
    for (int a = 0; a < 4; ++a) {
      const float base = bbase + bc.sg[it * 4 + a];
      S[it][4 * a] = base; S[it][4 * a + 1] = base + bc.sq1; S[it][4 * a + 2] = base + bc.sq2; S[it][4 * a + 3] = base + bc.sq3;
    }
#pragma unroll
  for (int s = 0; s < 4; ++s)
#pragma unroll
    for (int it = 0; it < 2; ++it) {
      const bf16x8 kf = *(const bf16x8*)(Ks + (it * 32 + r) * 144 + s * 32 + hf * 16);
      S[it] = MFMA(kf, qf[s], S[it]);
    }
}

template <int KS, int MASK> DI bool valid_d(int delta, int it, int e) {
  const int d = delta - KS * kappa(it, e);
  if constexpr (MASK == 1) return d >= 0;
  if constexpr (MASK == 2) return d < 512;
  return true;
}

template <int KS, int MASK>
DI float softmax_step(f32x16 (&S)[2], int delta, float& mrun, float& lrun) {
  float mx = mrun;
#pragma unroll
  for (int it = 0; it < 2; ++it)
#pragma unroll
    for (int e = 0; e < 16; ++e) {
      if constexpr (MASK != 0) S[it][e] = valid_d<KS, MASK>(delta, it, e) ? S[it][e] : NEGB;
      mx = fmaxf(mx, S[it][e]);
    }
  mx = fmaxf(mx, __shfl_xor(mx, 32));
  const float alpha = __builtin_amdgcn_exp2f((mrun - mx) * L2E);
  mrun = mx;
  const float mxs = mx * L2E;
  float ls = 0.f;
#pragma unroll
  for (int it = 0; it < 2; ++it)
#pragma unroll
    for (int e = 0; e < 16; ++e) {
      float pe = __builtin_amdgcn_exp2f(fmaf(S[it][e], L2E, -mxs));
      if constexpr (MASK != 0) pe = valid_d<KS, MASK>(delta, it, e) ? pe : 0.f;
      S[it][e] = pe;
      ls += pe;
    }
  lrun = lrun * alpha + ls;
  return alpha;
}

DI bf16x8 pack8(const f32x16& x, int s2) {
  unsigned a = pack2(x[8 * s2 + 0], x[8 * s2 + 1]), b = pack2(x[8 * s2 + 2], x[8 * s2 + 3]);
  unsigned c = pack2(x[8 * s2 + 4], x[8 * s2 + 5]), d = pack2(x[8 * s2 + 6], x[8 * s2 + 7]);
  uint4 u = make_uint4(a, b, c, d);
  return __builtin_bit_cast(bf16x8, u);
}

DI void pv_accum(const char* VTs, const f32x16 (&P)[2], f32x16 (&O)[2], int lane) {
  lane = launder(lane);
  const int r = lane & 31, hf = lane >> 5;
#pragma unroll
  for (int it = 0; it < 2; ++it)
#pragma unroll
    for (int s2 = 0; s2 < 2; ++s2) {
      const bf16x8 pf = pack8(P[it], s2);
#pragma unroll
      for (int dt = 0; dt < 2; ++dt) {
        const char* ptr = VTs + (dt * 32 + r) * 144 + (it * 32 + 16 * s2 + 4 * hf) * 2;
        const s16x4 lo = *(const s16x4*)ptr;
        const s16x4 hi = *(const s16x4*)(ptr + 16);
        const bf16x8 vf = __builtin_shufflevector(lo, hi, 0, 1, 2, 3, 4, 5, 6, 7);
        O[dt] = MFMA(vf, pf, O[dt]);
      }
    }
}

DI void zero_tiles(f32x16 (&O)[2]) {
#pragma unroll
  for (int a = 0; a < 2; ++a)
#pragma unroll
    for (int e = 0; e < 16; ++e) O[a][e] = 0.f;
}

template <bool FIRST>
DI void out_accum(char* outw, const f32x16 (&O)[2], float scale, int lane) {
  lane = launder(lane);
  const int r = lane & 31, hf = lane >> 5;
#pragma unroll
  for (int dt = 0; dt < 2; ++dt)
#pragma unroll
    for (int a = 0; a < 4; ++a) {
      uint2* ptr = (uint2*)(outw + r * 144 + (dt * 32 + 8 * a + 4 * hf) * 2);
      float v0 = O[dt][4 * a] * scale, v1 = O[dt][4 * a + 1] * scale;
      float v2 = O[dt][4 * a + 2] * scale, v3 = O[dt][4 * a + 3] * scale;
      if constexpr (!FIRST) {
        const uint2 old = *ptr;
        v0 += lo_bf(old.x); v1 += hi_bf(old.x); v2 += lo_bf(old.y); v3 += hi_bf(old.y);
      }
      *ptr = make_uint2(pack2(v0, v1), pack2(v2, v3));
    }
}

DI void cmp_probs(f32x16 (&S)[2], int delta, float mfin, float invl) {
  const float mxs = mfin * L2E;
#pragma unroll
  for (int it = 0; it < 2; ++it)
#pragma unroll
    for (int e = 0; e < 16; ++e) {
      const float pe = __builtin_amdgcn_exp2f(fmaf(S[it][e], L2E, -mxs)) * invl;
      S[it][e] = valid_d<16, 1>(delta, it, e) ? pe : 0.f;
    }
}

DI void attn_item(const Params& p, int b, int item, char* smem) {
  const int h = item < 128 ? 1 : 0;
  const int qh = 127 - (item & 127);
  const int qb = qh >> 1;
  const int tid = threadIdx.x, lane = tid & 63;
  const int g = __builtin_amdgcn_readfirstlane(tid >> 6);
  const int r = lane & 31, hf = lane >> 5;
  const int head = h * 4 + g;
  const float slope = sgpr_f(__builtin_amdgcn_exp2f(-(float)(head + 1)));
  const BiasC bc1 = make_bias<1>(head + 1), bc16 = make_bias<16>(head + 1);
  const u16* proj = (const u16*)(p.ws + OFF_PROJ);
  const int q0 = qh * 32;
  const size_t m0 = (size_t)b * T + (size_t)q0;
  const int tq = q0 + r;
  char* Ks = smem + A_KS;
  char* VTs = smem + A_VT;
  float* IMPs = (float*)(smem + A_IMP);
  unsigned long long* SELM = (unsigned long long*)(smem + A_SEL);
  unsigned* UN = (unsigned*)(smem + A_SEL + 32 * 8);
  char* outw = smem + A_OUT + g * 32 * 144;

  bf16x8 qf[4];
  float gate[3];
  {
    const u16* qrow = proj + prow(m0 + r);
#pragma unroll
    for (int s = 0; s < 4; ++s) qf[s] = *(const bf16x8*)(qrow + head * 64 + s * 16 + hf * 8);
#pragma unroll
    for (int br = 0; br < 3; ++br) gate[br] = bf2f(qrow[GL_OFF + head * 3 + br]);
  }
  if (tid < 2) UN[tid] = 0;

  f32x16 S[2], O[2];
  float mrun, lrun;

  const int nkt = ((q0 >> 4) + 1 + 63) >> 6;
  const u16* kc = (const u16*)(p.ws + OFF_KCN) + (size_t)(b * 2 + h) * 256 * 64;
  const u16* vc = (const u16*)(p.ws + OFF_VCT) + (size_t)(b * 2 + h) * 64 * 256;
  mrun = NEGB; lrun = 0.f;
  auto cmp_issue = [&](int kt) { return tile_issue(kc + (size_t)kt * 64 * 64, 64, vc + kt * 64, 256); };
  run_tiles(smem, nkt, cmp_issue, [&](int kt) {
    const int delta = tq - 31 - 1024 * kt - 64 * hf;
    qk_scores(Ks, qf, S, -slope * (float)delta, bc16, lane);
    softmax_step<16, 1>(S, delta, mrun, lrun);
  });
  float invl, mfin;
  {
    const float lt = lrun + __shfl_xor(lrun, 32);
    invl = lt > 0.f ? 1.f / lt : 0.f;
    mfin = mrun;
  }
  zero_tiles(O);
  run_tiles(smem, nkt, cmp_issue, [&](int kt) {
    const int delta = tq - 31 - 1024 * kt - 64 * hf;
    qk_scores(Ks, qf, S, -slope * (float)delta, bc16, lane);
    cmp_probs(S, delta, mfin, invl);
    pv_accum(VTs, S, O, lane);
  });
  out_accum<true>(outw, O, gate[0], lane);
  zero_tiles(O);
  run_tiles(smem, nkt, cmp_issue, [&](int kt) {
    const int delta = tq - 31 - 1024 * kt - 64 * hf;
    qk_scores(Ks, qf, S, -slope * (float)delta, bc16, lane);
    cmp_probs(S, delta, mfin, invl);
#pragma unroll
    for (int it = 0; it < 2; ++it)
#pragma unroll
      for (int s2 = 0; s2 < 2; ++s2) {
        const bf16x8 pf = pack8(S[it], s2);
#pragma unroll
        for (int dt = 0; dt < 2; ++dt) {
          const int j = dt * 32 + r;
          bf16x8 ov;
          const int nb0 = 64 * kt + 4 * hf - 4 * j + 1;
#pragma unroll
          for (int e = 0; e < 8; ++e) {
            const unsigned dn = (unsigned)(nb0 + it * 32 + 16 * s2 + 8 * (e >> 2) + (e & 3));
            ov[e] = (dn <= 4u) ? (short)0x3C00 : (short)0;
          }
          O[dt] = MFMA(ov, pf, O[dt]);
        }
      }
  });
  for (int round = 0; round < 4; ++round) {
    __syncthreads();
    if (g == round) {
#pragma unroll
      for (int dt = 0; dt < 2; ++dt)
#pragma unroll
        for (int a = 0; a < 4; ++a) {
          float4* ptr = (float4*)(IMPs + r * 68 + dt * 32 + 8 * a + 4 * hf);
          float4 v = make_float4(O[dt][4 * a], O[dt][4 * a + 1], O[dt][4 * a + 2], O[dt][4 * a + 3]);
          if (round != 0) { const float4 o = *ptr; v.x += o.x; v.y += o.y; v.z += o.z; v.w += o.w; }
          *ptr = v;
        }
    }
  }
  __syncthreads();
  {
    const int t = tid >> 3, j0 = (tid & 7) * 8;
#pragma unroll
    for (int e = 0; e < 8; ++e) {
      const int j = j0 + e;
      float v = IMPs[t * 68 + j];
      const bool forced = (j == 0) || (j == qb) || (j == qb - 1);
      v = forced ? 1e6f : (j > qb ? NEGB : v);
      IMPs[t * 68 + j] = v;
    }
  }
  __syncthreads();
  for (int i = 0; i < 8; ++i) {
    const int t = g * 8 + i;
    const float vj = IMPs[t * 68 + lane];
    int rank = 0;
#pragma unroll 1
    for (int c4 = 0; c4 < 16; ++c4) {
      const float4 v = *(const float4*)(IMPs + t * 68 + c4 * 4);
      const int rel = lane - c4 * 4;
      rank += (v.x > vj || (v.x == vj && 0 < rel)) ? 1 : 0;
      rank += (v.y > vj || (v.y == vj && 1 < rel)) ? 1 : 0;
      rank += (v.z > vj || (v.z == vj && 2 < rel)) ? 1 : 0;
      rank += (v.w > vj || (v.w == vj && 3 < rel)) ? 1 : 0;
    }
    const unsigned long long msk = __ballot(rank < 16);
    if (lane == 0) {
      SELM[t] = msk;
      atomicOr(&UN[0], (unsigned)(msk & 0xffffffffull));
      atomicOr(&UN[1], (unsigned)(msk >> 32));
    }
  }
  __syncthreads();
  const unsigned long long selm = SELM[r];
  unsigned long long un;
  {
    unsigned u0 = __builtin_amdgcn_readfirstlane(UN[0]), u1 = __builtin_amdgcn_readfirstlane(UN[1]);
    un = (unsigned long long)u0 | ((unsigned long long)u1 << 32);
    un &= (qb == 63) ? ~0ull : ((1ull << (qb + 1)) - 1ull);
  }

  {
    unsigned char* JL = (unsigned char*)(smem + A_JL);
    if (tid < 64 && ((un >> tid) & 1ull)) JL[__builtin_popcountll(tid == 63 ? 0ull : (un >> (tid + 1)))] = (unsigned char)tid;
    const int nsel = __builtin_popcountll(un);
    __syncthreads();
    const u16* ksb = proj + prow((size_t)b * T) + KS_OFF + h * 64;
    const u16* vsb = (const u16*)(p.ws + OFF_VST) + (size_t)(b * 2 + h) * 64 * T;
    mrun = NEGB; lrun = 0.f;
    zero_tiles(O);
    run_tiles(smem, nsel,
      [&](int i) { const int j = JL[i]; return tile_issue(ksb + (size_t)j * 64 * NP, NP, vsb + j * 64, T); },
      [&](int i) {
        const int j = __builtin_amdgcn_readfirstlane((int)JL[i]);
        const int delta = tq - j * 64 - 4 * hf;
        const bool sel = (selm >> j) & 1ull;
        qk_scores(Ks, qf, S, sel ? -slope * (float)delta : NEGB, bc1, lane);
        float alpha;
        if (j == qb) alpha = softmax_step<1, 1>(S, delta, mrun, lrun);
        else alpha = softmax_step<1, 0>(S, delta, mrun, lrun);
        if (__builtin_amdgcn_ballot_w64(alpha != 1.f) != 0ull) {
#pragma unroll
          for (int dt = 0; dt < 2; ++dt)
#pragma unroll
            for (int e = 0; e < 16; ++e) O[dt][e] *= alpha;
        }
        pv_accum(VTs, S, O, lane);
      });
    const float lt = lrun + __shfl_xor(lrun, 32);
    out_accum<false>(outw, O, lt > 0.f ? gate[1] / lt : 0.f, lane);
  }
  {
    const u16* kwb = proj + prow((size_t)b * T) + KW_OFF + h * 64;
    const u16* vwb = (const u16*)(p.ws + OFF_VWT) + (size_t)(b * 2 + h) * 64 * T;
    mrun = NEGB; lrun = 0.f;
    zero_tiles(O);
    const int jlo = qb - 8 > 0 ? qb - 8 : 0;
    run_tiles(smem, qb - jlo + 1,
      [&](int i) { const int j = qb - i; return tile_issue(kwb + (size_t)j * 64 * NP, NP, vwb + j * 64, T); },
      [&](int i) {
        const int j = qb - i;
        const int delta = tq - j * 64 - 4 * hf;
        qk_scores(Ks, qf, S, -slope * (float)delta, bc1, lane);
        float alpha;
        if (j == qb) alpha = softmax_step<1, 1>(S, delta, mrun, lrun);
        else if (j == qb - 8) alpha = softmax_step<1, 2>(S, delta, mrun, lrun);
        else alpha = softmax_step<1, 0>(S, delta, mrun, lrun);
        if (__builtin_amdgcn_ballot_w64(alpha != 1.f) != 0ull) {
#pragma unroll
          for (int dt = 0; dt < 2; ++dt)
#pragma unroll
            for (int e = 0; e < 16; ++e) O[dt][e] *= alpha;
        }
        pv_accum(VTs, S, O, lane);
      });
    const float lt = lrun + __shfl_xor(lrun, 32);
    out_accum<false>(outw, O, lt > 0.f ? gate[2] / lt : 0.f, lane);
  }
  __syncthreads();
  {
    u16* mix = (u16*)(p.ws + OFF_MIX);
#pragma unroll
    for (int i = 0; i < 4; ++i) {
      const int t = (lane >> 3) + 8 * i, c = lane & 7;
      const uint4 v = *(const uint4*)(outw + t * 144 + c * 16);
      *(uint4*)(mix + (m0 + t) * 1024 + head * 64 + c * 8) = v;
    }
  }
  __syncthreads();
}

constexpr int SC = 16;
DI void scan_item(const Params& p, int b, int h, int half, char* smem, unsigned* pgen, unsigned kp) {
  const int tid = threadIdx.x;
  const int rp = tid >> 3, cg = tid & 7;
  float* Rl = (float*)smem;
  float* Wl = Rl + SC * 64;
  float* Kl = Wl + SC * 64;
  float* Vl = Kl + SC * 64;
  float* Al = Vl + SC * 64;
  float* Bl = Al + SC * 64;
  float* Yl = Bl + SC * 64;
  float* BON = Yl + SC * 64;
  const u16* proj = (const u16*)(p.ws + OFF_PROJ);
  const float* Wg = (const float*)(p.ws + OFF_BUFA);
  const float* KPg = p.out + (size_t)b * (4096 * 1024) - (size_t)b * T * 512;
  const float* KKg = KPg + (size_t)4096 * 512;
  u16* mix = (u16*)(p.ws + OFF_MIX);
  const int ls = tid >> 4, lc = (tid & 15) * 4;
  const int hc = h * 64 + lc;

  f32x2 St[4];
#pragma unroll
  for (int i = 0; i < 4; ++i) St[i] = (f32x2){0.f, 0.f};

  float* CT = BON + 64;
  __syncthreads();
  if (tid < 64) {
    CT[tid] = p.mu[h * 64 + tid]; CT[64 + tid] = p.mu[1024 + h * 64 + tid]; CT[128 + tid] = p.r_k[h * 64 + tid];
    CT[192 + tid] = p.lnx_w[h * 64 + tid]; CT[256 + tid] = p.lnx_b[h * 64 + tid];
  }
  struct ScanRaw { float4 w, k, kk, a; uint2 rc, vc, rp, vp; };
  float4 pw, pk, pkk, pa, pr, pv;
  float pbon;
  auto prefetch = [&](int c, ScanRaw& R) {
    const int t = c * SC + ls;
    const size_t m = (size_t)b * T + t;
    R.w = *(const float4*)(Wg + m * 512 + hc);
    R.k = *(const float4*)(KPg + m * 512 + hc);
    R.kk = *(const float4*)(KKg + m * 512 + hc);
    R.a = *(const float4*)(aaptr(p.ws, m) + hc);
    R.rc = *(const uint2*)(proj + prow(m) + R_OFF + hc);
    R.vc = *(const uint2*)(proj + prow(m) + V_OFF + hc);
    R.rp = make_uint2(0, 0); R.vp = make_uint2(0, 0);
    if (t > 0) { R.rp = *(const uint2*)(proj + prow(m - 1) + R_OFF + hc); R.vp = *(const uint2*)(proj + prow(m - 1) + V_OFF + hc); }
  };
  auto convert = [&](const ScanRaw& R) {
    const float4 mu_r = *(const float4*)(CT + lc);
    const float4 mu_v = *(const float4*)(CT + 64 + lc);
    const float4 rk = *(const float4*)(CT + 128 + lc);
    pw = R.w; pk = R.k; pkk = R.kk; pa = R.a;
    float c0, p0;
    c0 = lo_bf(R.rc.x); p0 = lo_bf(R.rp.x); pr.x = c0 + (p0 - c0) * mu_r.x;
    c0 = hi_bf(R.rc.x); p0 = hi_bf(R.rp.x); pr.y = c0 + (p0 - c0) * mu_r.y;
    c0 = lo_bf(R.rc.y); p0 = lo_bf(R.rp.y); pr.z = c0 + (p0 - c0) * mu_r.z;
    c0 = hi_bf(R.rc.y); p0 = hi_bf(R.rp.y); pr.w = c0 + (p0 - c0) * mu_r.w;
    c0 = lo_bf(R.vc.x); p0 = lo_bf(R.vp.x); pv.x = c0 + (p0 - c0) * mu_v.x;
    c0 = hi_bf(R.vc.x); p0 = hi_bf(R.vp.x); pv.y = c0 + (p0 - c0) * mu_v.y;
    c0 = lo_bf(R.vc.y); p0 = lo_bf(R.vp.y); pv.z = c0 + (p0 - c0) * mu_v.z;
    c0 = hi_bf(R.vc.y); p0 = hi_bf(R.vp.y); pv.w = c0 + (p0 - c0) * mu_v.w;
    pbon = row16_sum(pr.x * pk.x * rk.x + pr.y * pk.y * rk.y + pr.z * pk.z * rk.z + pr.w * pk.w * rk.w);
  };
  auto override_t0 = [&]() {
    const float* t0 = (const float*)(p.ws + OFF_T0) + (size_t)b * 17 * 64;
    const float4 r0 = *(const float4*)(t0 + h * 64 + lc);
    const float4 k0 = *(const float4*)(t0 + (8 + h) * 64 + lc);
    float av[4] = {p.a0[hc], p.a0[hc + 1], p.a0[hc + 2], p.a0[hc + 3]};
    for (int j = 0; j < 64; ++j) {
      const float xj = t0[16 * 64 + j];
      const float4 a2r = *(const float4*)(p.a2 + (size_t)j * 512 + hc);
      av[0] += xj * a2r.x; av[1] += xj * a2r.y; av[2] += xj * a2r.z; av[3] += xj * a2r.w;
    }
    const float4 kkw = *(const float4*)(p.k_k + hc);
    const float4 kaw = *(const float4*)(p.k_a + hc);
    const float4 rk = *(const float4*)(CT + 128 + lc);
    const float kv[4] = {k0.x, k0.y, k0.z, k0.w}, kkc[4] = {kkw.x, kkw.y, kkw.z, kkw.w}, kac[4] = {kaw.x, kaw.y, kaw.z, kaw.w};
    float kkv[4], kpv[4], aa[4], ssq = 0.f;
#pragma unroll
    for (int e = 0; e < 4; ++e) { aa[e] = sigmoidf_(av[e]); kkv[e] = kv[e] * kkc[e]; ssq += kkv[e] * kkv[e]; kpv[e] = kv[e] * (1.f + (aa[e] - 1.f) * kac[e]); }
    ssq = row16_sum(ssq);
    const float inv = rsqrtf(fmaxf(ssq, 1e-24f));
    pr = r0;
    pk = make_float4(kpv[0], kpv[1], kpv[2], kpv[3]);
    pkk = make_float4(kkv[0] * inv, kkv[1] * inv, kkv[2] * inv, kkv[3] * inv);
    pa = make_float4(aa[0], aa[1], aa[2], aa[3]);
    pbon = row16_sum(pr.x * pk.x * rk.x + pr.y * pk.y * rk.y + pr.z * pk.z * rk.z + pr.w * pk.w * rk.w);
  };
  auto chunk = [&](int c, ScanRaw& R) {
    __syncthreads();
    convert(R);
    if (c == 0 && ls == 0) override_t0();
    *(float4*)(Rl + ls * 64 + lc) = pr;
    *(float4*)(Wl + ls * 64 + lc) = pw;
    *(float4*)(Kl + ls * 64 + lc) = pk;
    *(float4*)(Vl + ls * 64 + lc) = pv;
    *(float4*)(Al + ls * 64 + lc) = make_float4(-pkk.x, -pkk.y, -pkk.z, -pkk.w);
    *(float4*)(Bl + ls * 64 + lc) = make_float4(pkk.x * pa.x, pkk.y * pa.y, pkk.z * pa.z, pkk.w * pa.w);
    if ((tid & 15) == 0) BON[ls] = pbon;
    __syncthreads();
    if (c + 2 == (T / SC) / 4) {
      if (tid == 0) {
        while (__hip_atomic_load(pgen, __ATOMIC_RELAXED, __HIP_MEMORY_SCOPE_AGENT) < kp) __builtin_amdgcn_s_sleep(2);
        __builtin_amdgcn_fence(__ATOMIC_ACQUIRE, "agent");
        asm volatile("s_waitcnt vmcnt(0)" ::: "memory");
      }
      __syncthreads();
    }
    if (c + 2 < T / SC) prefetch(c + 2, R);
#pragma unroll 1
    for (int sg = 0; sg < SC; sg += 4) {
      float yy[4];
#pragma unroll
      for (int s4 = 0; s4 < 4; ++s4) {
        const int s = sg + s4;
        const f32x2* a2 = (const f32x2*)(Al + s * 64 + cg * 8);
        const f32x2* w2 = (const f32x2*)(Wl + s * 64 + cg * 8);
        const f32x2* b2 = (const f32x2*)(Bl + s * 64 + cg * 8);
        const f32x2* k2 = (const f32x2*)(Kl + s * 64 + cg * 8);
        const f32x2* r2 = (const f32x2*)(Rl + s * 64 + cg * 8);
        f32x2 o[20];
#pragma unroll
        for (int i = 0; i < 4; ++i) { o[i] = a2[i]; o[4 + i] = w2[i]; o[8 + i] = b2[i]; o[12 + i] = k2[i]; o[16 + i] = r2[i]; }
        const float vr = Vl[s * 64 + 32 * half + rp];
        f32x2 p0 = St[0] * o[0], p1 = St[1] * o[1];
        p0 = __builtin_elementwise_fma(St[2], o[2], p0); p1 = __builtin_elementwise_fma(St[3], o[3], p1);
        const float sa = oct_sum((p0.x + p0.y) + (p1.x + p1.y));
        const f32x2 sv = {sa, sa}, vv = {vr, vr};
        f32x2 y0 = {0.f, 0.f}, y1 = {0.f, 0.f};
#pragma unroll
        for (int i = 0; i < 4; i += 2) {
          St[i] = __builtin_elementwise_fma(St[i], o[4 + i], __builtin_elementwise_fma(sv, o[8 + i], vv * o[12 + i]));
          St[i + 1] = __builtin_elementwise_fma(St[i + 1], o[5 + i], __builtin_elementwise_fma(sv, o[9 + i], vv * o[13 + i]));
          y0 = __builtin_elementwise_fma(St[i], o[16 + i], y0);
          y1 = __builtin_elementwise_fma(St[i + 1], o[17 + i], y1);
        }
        yy[s4] = oct_sum((y0.x + y0.y) + (y1.x + y1.y));
      }
      if (cg == 0) {
#pragma unroll
        for (int s4 = 0; s4 < 4; ++s4) Yl[(sg + s4) * 32 + rp] = yy[s4];
      }
    }
    __syncthreads();
    {
      const int t = c * SC + ls;
      const size_t m = (size_t)b * T + t;
      const int j2 = (tid & 15) * 2;
      const f32x2 y2 = *(const f32x2*)(Yl + ls * 32 + j2);
      *(unsigned*)(mix + m * 1024 + 512 + h * 64 + 32 * half + j2) = pack2(y2.x, y2.y);
      if (half == 0 && (tid & 15) == 0) ((float*)(p.ws + OFF_BON))[m * 8 + h] = BON[ls];
    }
  };
  ScanRaw RA, RB;
  prefetch(0, RA);
  prefetch(1, RB);
  __builtin_amdgcn_s_setprio(3);
#pragma unroll 1
  for (int c = 0; c < T / SC; c += 2) {
    chunk(c, RA);
    chunk(c + 1, RB);
  }
  __builtin_amdgcn_s_setprio(0);
  __syncthreads();
}


struct GnRaw { uint2 yr, vc, vp, gg; float bon; };
DI GnRaw gn_load(const Params& p, size_t m, int ml, int h, int hc) {
  const u16* proj = (const u16*)(p.ws + OFF_PROJ);
  const u16* mix = (const u16*)(p.ws + OFF_MIX);
  GnRaw r;
  r.yr = *(const uint2*)(mix + m * 1024 + 512 + hc);
  r.vc = *(const uint2*)(proj + prow(m) + V_OFF + hc);
  r.vp = make_uint2(0, 0);
  if (ml > 0) r.vp = *(const uint2*)(proj + prow(m - 1) + V_OFF + hc);
  r.bon = ((const float*)(p.ws + OFF_BON))[m * 8 + h];
  r.gg = *(const uint2*)((const u16*)(p.ws + OFF_G) + m * 512 + hc);
  return r;
}
DI void gn_finish(const Params& p, const GnRaw& r, size_t m, int hc, const float4& mv, const float4& lw, const float4& lb) {
  u16* yp = (u16*)(p.ws + OFF_MIX) + m * 1024 + 512 + hc;
  const float y0 = lo_bf(r.yr.x), y1 = hi_bf(r.yr.x), y2 = lo_bf(r.yr.y), y3 = hi_bf(r.yr.y);
  const float mean = row16_sum(y0 + y1 + y2 + y3) * (1.f / 64.f);
  const float d0 = y0 - mean, d1 = y1 - mean, d2 = y2 - mean, d3 = y3 - mean;
  const float var = row16_sum(d0 * d0 + d1 * d1 + d2 * d2 + d3 * d3) * (1.f / 64.f);
  const float rs = rsqrtf(var + 64e-5f);
  float c0, p0;
  c0 = lo_bf(r.vc.x); p0 = lo_bf(r.vp.x); const float v0 = c0 + (p0 - c0) * mv.x;
  c0 = hi_bf(r.vc.x); p0 = hi_bf(r.vp.x); const float v1 = c0 + (p0 - c0) * mv.y;
  c0 = lo_bf(r.vc.y); p0 = lo_bf(r.vp.y); const float v2 = c0 + (p0 - c0) * mv.z;
  c0 = hi_bf(r.vc.y); p0 = hi_bf(r.vp.y); const float v3 = c0 + (p0 - c0) * mv.w;
  const float o0 = (d0 * rs * lw.x + lb.x + r.bon * v0) * lo_bf(r.gg.x);
  const float o1 = (d1 * rs * lw.y + lb.y + r.bon * v1) * hi_bf(r.gg.x);
  const float o2 = (d2 * rs * lw.z + lb.z + r.bon * v2) * lo_bf(r.gg.y);
  const float o3 = (d3 * rs * lw.w + lb.w + r.bon * v3) * hi_bf(r.gg.y);
  *(uint2*)yp = make_uint2(pack2(o0, o1), pack2(o2, o3));
}
DI void gn_item(const Params& p, int b, int idx) {
  const int tid = threadIdx.x;
  const int lc = (tid & 15) * 4;
  const int qa = idx * 16 + (tid >> 4), qb2 = qa + 16384;
  const int mla = qa >> 3, ha = qa & 7, mlb = qb2 >> 3, hb = qb2 & 7;
  const int hc = ha * 64 + lc;
  const size_t ma = (size_t)b * T + mla, mb = (size_t)b * T + mlb;
  const GnRaw ra = gn_load(p, ma, mla, ha, hc);
  const GnRaw rb = gn_load(p, mb, mlb, hb, hc);
  const float4 mv = *(const float4*)(p.mu + 1024 + hc);
  const float4 lw = *(const float4*)(p.lnx_w + hc);
  const float4 lb = *(const float4*)(p.lnx_b + hc);
  gn_finish(p, ra, ma, hc, mv, lw, lb);
  gn_finish(p, rb, mb, hc, mv, lw, lb);
}

DI void grid_barrier(unsigned* ctr, unsigned target) {
  asm volatile("s_waitcnt vmcnt(0)" ::: "memory");
  __syncthreads();
  if (threadIdx.x == 0) {
    __builtin_amdgcn_s_waitcnt(0);
    __builtin_amdgcn_fence(__ATOMIC_RELEASE, "agent");
    asm volatile("s_waitcnt vmcnt(0)" ::: "memory");
    __hip_atomic_fetch_add(ctr, 1u, __ATOMIC_RELAXED, __HIP_MEMORY_SCOPE_AGENT);
    while (__hip_atomic_load(ctr, __ATOMIC_RELAXED, __HIP_MEMORY_SCOPE_AGENT) < target) __builtin_amdgcn_s_sleep(1);
    __builtin_amdgcn_fence(__ATOMIC_ACQUIRE, "agent");
    asm volatile("s_waitcnt vmcnt(0)" ::: "memory");
  }
  __syncthreads();
}

DI void xcd_barrier(unsigned* ctr, unsigned cnt, unsigned k) {
  asm volatile("s_waitcnt vmcnt(0)" ::: "memory");
  __syncthreads();
  if (threadIdx.x == 0) {
    __builtin_amdgcn_s_waitcnt(0);
    const unsigned old = __hip_atomic_fetch_add(ctr, 1u, __ATOMIC_RELAXED, __HIP_MEMORY_SCOPE_AGENT);
    if (old + 1u == cnt * k) {
      __builtin_amdgcn_fence(__ATOMIC_RELEASE, "agent");
      asm volatile("s_waitcnt vmcnt(0)" ::: "memory");
      __hip_atomic_fetch_add(ctr + 1, 1u, __ATOMIC_RELAXED, __HIP_MEMORY_SCOPE_AGENT);
    } else {
      while (__hip_atomic_load(ctr + 1, __ATOMIC_RELAXED, __HIP_MEMORY_SCOPE_AGENT) < k) __builtin_amdgcn_s_sleep(1);
    }
    __builtin_amdgcn_fence(__ATOMIC_ACQUIRE, "agent");
    asm volatile("s_waitcnt vmcnt(0)" ::: "memory");
  }
  __syncthreads();
}

DI void t0_item(const Params& p, int item, char* smem) {
  const int b = item / 17, grp = item - b * 17;
  const int tid = threadIdx.x;
  float* xs = (float*)smem;
  float* red = xs + 1024;
  __syncthreads();
  const float* xr = p.x + (size_t)b * T * 1024;
  float ss = 0.f;
  for (int i = tid; i < 1024; i += 256) { const float v = xr[i]; ss += v * v; }
  ss = wave_sum(ss);
  __syncthreads();
  if ((tid & 63) == 0) red[tid >> 6] = ss;
  __syncthreads();
  const float sc = rsqrtf((red[0] + red[1] + red[2] + red[3]) * (1.f / 1024.f) + 1e-6f);
  for (int i = tid; i < 1024; i += 256) xs[i] = xr[i] * sc * p.ln_mix_g[i];
  __syncthreads();
  const int c = tid & 63, kp = tid >> 6;
  const int rc = grp < 8 ? grp * 64 + c : (grp < 16 ? 512 + (grp - 8) * 64 + c : 1600 + c);
  const float* wc = p.w_in + 1304 + rc;
  float a = 0.f;
#pragma unroll 8
  for (int k = kp * 256; k < kp * 256 + 256; ++k) a += xs[k] * wc[(size_t)k * 3096];
  __syncthreads();
  red[tid] = a;
  __syncthreads();
  if (tid < 64) {
    const float v = red[tid] + red[tid + 64] + red[tid + 128] + red[tid + 192];
    ((float*)(p.ws + OFF_T0))[(size_t)(b * 17 + grp) * 64 + tid] = v * (1.f - p.mu[rc]);
  }
  __syncthreads();
}


struct XcdInfo { int pi, npop, rank, cnt; };
DI XcdInfo xcd_setup(unsigned* ctrbase, char* smem) {
  int* sx = (int*)(smem + 73728 - 64);
  if (threadIdx.x == 0) {
    const unsigned xcc = (unsigned)__builtin_amdgcn_s_getreg((3 << 11) | 20) & 0xFu;
    unsigned* census = ctrbase + 16;
    const unsigned rank = __hip_atomic_fetch_add(&census[xcc], 1u, __ATOMIC_RELAXED, __HIP_MEMORY_SCOPE_AGENT);
    for (;;) {
      unsigned sum = 0, npop = 0, pi = 0, mine = 0;
      for (unsigned j = 0; j < 16; ++j) {
        const unsigned v = __hip_atomic_load(&census[j], __ATOMIC_RELAXED, __HIP_MEMORY_SCOPE_AGENT);
        sum += v; npop += (v > 0u) ? 1u : 0u; pi += (v > 0u && j < xcc) ? 1u : 0u; mine = (j == xcc) ? v : mine;
      }
      if (sum == gridDim.x) { sx[0] = (int)pi; sx[1] = (int)npop; sx[2] = (int)rank; sx[3] = (int)mine; break; }
      __builtin_amdgcn_s_sleep(2);
    }
  }
  __syncthreads();
  XcdInfo X;
  X.pi = sx[0]; X.npop = sx[1]; X.rank = sx[2]; X.cnt = sx[3];
  __syncthreads();
  return X;
}
#define FOR_BATCH(b) for (int b = X.pi; b < 8; b += X.npop)
#define FOR_ITEMS(i, n) for (int i = X.rank; i < (n); i += X.cnt)

#ifndef PH
#define PH 0xFFF
#endif
#ifndef USE_CG
#define USE_CG 0
#endif
#ifndef DBL
#define DBL 0
#endif
#define PM(bit) (((DBL) & (bit)) ? 2 : 1)
__global__ void __launch_bounds__(256, 2) fwd_megakernel(Params p) {
  __shared__ __attribute__((aligned(16))) char smem[73728];
  cg::grid_group grid = cg::this_grid();
  const int nb = gridDim.x, bid = blockIdx.x, tid = threadIdx.x;
  unsigned* ctrs = (unsigned*)(p.ws + OFF_CTR);
  unsigned* bar = ctrs + 32;
  const XcdInfo X = xcd_setup(ctrs, smem);
  unsigned* xbar = ctrs + 64 + 32 * X.pi;

  {
    constexpr int N0 = 800, N1 = N0 + 256, N2 = N1 + 1024, N3 = N2 + 1024, N4 = N3 + 64, N5 = N4 + 64, N6 = N5 + 8, N7 = N6 + 8, N8 = N7 + 16;
    constexpr int NTOT = N8 + 65;
    for (int it0 = bid; it0 < NTOT * PM(8); it0 += nb) {
      const int it = it0 % NTOT;
      if (it < N0) { int i = it; transpose_tile(p.w_in, 3096, (u16*)(p.ws + OFF_WTIN), 1024, (i % 16) * 64, (i / 16) * 64, true, smem); }
      else if (it < N1) { int i = it - N0; transpose_tile(p.w_out, 1024, (u16*)(p.ws + OFF_WTOUT), 1024, (i % 16) * 64, (i / 16) * 64, false, smem); }
      else if (it < N2) { int i = it - N1; transpose_tile(p.w_ff1, 4096, (u16*)(p.ws + OFF_WTFF1), 1024, (i % 16) * 64, (i / 16) * 64, false, smem); }
      else if (it < N3) { int i = it - N2; transpose_tile(p.w_ff2, 1024, (u16*)(p.ws + OFF_WTFF2), 4096, (i % 64) * 64, (i / 64) * 64, false, smem); }
      else if (it < N4) { int i = it - N3; transpose_tile(p.ck_w1, 128, (u16*)(p.ws + OFF_CW1T), 2048, (i % 32) * 64, (i / 32) * 64, false, smem); }
      else if (it < N5) { int i = it - N4; transpose_tile(p.cv_w1, 128, (u16*)(p.ws + OFF_CW1T) + 128 * 2048, 2048, (i % 32) * 64, (i / 32) * 64, false, smem); }
      else if (it < N6) { int i = it - N5; transpose_tile(p.w2, 512, (u16*)(p.ws + OFF_W2T), 64, 0, i * 64, false, smem); }
      else if (it < N7) { int i = it - N6; transpose_tile(p.a2, 512, (u16*)(p.ws + OFF_A2T), 64, 0, i * 64, false, smem); }
      else if (it < N8) { int i = it - N7; transpose_tile(p.g2, 512, (u16*)(p.ws + OFF_G2T), 128, (i % 2) * 64, (i / 2) * 64, false, smem); }
      else if (it < N8 + 64) {
        const int idx = it - N8, kv = idx & 1, kc = idx >> 1;
        const float* pos = kv ? p.cv_pos : p.ck_pos;
        const float* w1 = kv ? p.cv_w1 : p.ck_w1;
        const int j = tid & 127, hh = tid >> 7;
        float a = 0.f;
#pragma unroll 8
        for (int k = kc * 64 + hh * 32; k < kc * 64 + hh * 32 + 32; ++k) a += pos[k] * w1[(size_t)k * 128 + j];
        float* s = (float*)smem;
        __syncthreads();
        s[tid] = a;
        __syncthreads();
        if (tid < 128) ((float*)(p.ws + OFF_PBP))[(kv * 32 + kc) * 128 + tid] = s[tid] + s[tid + 128];
        __syncthreads();
      } else {
        u16* kcn = (u16*)(p.ws + OFF_KCN);
        u16* vct = (u16*)(p.ws + OFF_VCT);
        for (int i = tid; i < 16 * 64; i += 256) {
          const int bh = i >> 6, d = i & 63;
          kcn[((size_t)bh * 256 + 255) * 64 + d] = 0;
          vct[((size_t)bh * 64 + d) * 256 + 255] = 0;
        }
      }
    }
    FOR_BATCH(b) FOR_ITEMS(i, 1024 * PM(8)) rmsnorm_rows(p.x, p.ln_mix_g, (u16*)(p.ws + OFF_BUFA), b * 1024 + (i & 1023));
  }
  asm volatile("s_waitcnt vmcnt(0)" ::: "memory");
  grid.sync();
  FOR_BATCH(b) FOR_ITEMS(i0, 400 * PM(32)) {
    const int i = i0 % 400;
    const int tng = i / 80, rem = i - tng * 80;
    gemm_tile<G_INPROJ, true>(p, b * 16 + rem / 5, tng * 5 + rem % 5, 0, smem);
  }
  xcd_barrier(xbar, (unsigned)X.cnt, 1u);
  {
    const int NS = X.cnt >= 32 ? 16 : (X.cnt >> 1);
    const int PS = X.cnt - NS, pr = X.rank - NS;
    unsigned* pbar = xbar + 2;
    unsigned kp = 0;
#pragma unroll 1
    for (int stage = 0; stage < 2; ++stage) {
      FOR_BATCH(b) {
        const bool mine = (stage == 0) || (pr >= 0);
        const int start = stage == 0 ? X.rank : pr, stride = stage == 0 ? X.cnt : PS, lo = stage * 32, hi = stage == 0 ? 32 : 128;
        if (mine) {
          for (int i = lo + start; i < hi; i += stride) gemm_tile<G_RWW>(p, b * 32 + (i >> 2), i & 3, 0, smem);
          for (int i = lo + start; i < hi; i += stride) gemm_tile<G_RWA>(p, b * 32 + (i >> 2), i & 3, 0, smem);
        }
        if (stage == 0) {
          for (int i = X.rank; i < 17; i += X.cnt) t0_item(p, b * 17 + i, smem);
        } else {
          ++kp;
          if (pr < 0) {
            for (int i = X.rank; i < 16; i += NS) scan_item(p, b, i >> 1, i & 1, smem, pbar + 1, kp);
            if (tid == 0) {
              while (__hip_atomic_load(pbar + 1, __ATOMIC_RELAXED, __HIP_MEMORY_SCOPE_AGENT) < kp) __builtin_amdgcn_s_sleep(2);
              __builtin_amdgcn_fence(__ATOMIC_ACQUIRE, "agent");
              asm volatile("s_waitcnt vmcnt(0)" ::: "memory");
            }
            __syncthreads();
          } else {
            const bool cpool = PS > 8;
            const int st = cpool ? PS - 8 : PS, me = cpool ? pr - 8 : pr;
            for (int i = pr; i < 8; i += PS) gemm_tile<G_CMP>(p, b * 4 + (i >> 1), 0, i & 1, smem);
            if (me >= 0) {
              for (int i = me; i < 256; i += st) vtrans_item(p, ((i >> 7) << 10) | (b << 7) | (i & 127), smem);
            }
            asm volatile("s_waitcnt vmcnt(0)" ::: "memory");
            __syncthreads();
            if (tid == 0) {
              __builtin_amdgcn_s_waitcnt(0);
              const unsigned old = __hip_atomic_fetch_add(pbar, 1u, __ATOMIC_RELAXED, __HIP_MEMORY_SCOPE_AGENT);
              if (old + 1u == (unsigned)PS * kp) __hip_atomic_fetch_add(pbar + 1, 1u, __ATOMIC_RELAXED, __HIP_MEMORY_SCOPE_AGENT);
              else while (__hip_atomic_load(pbar + 1, __ATOMIC_RELAXED, __HIP_MEMORY_SCOPE_AGENT) < kp) __builtin_amdgcn_s_sleep(1);
              __builtin_amdgcn_fence(__ATOMIC_ACQUIRE, "agent");
              asm volatile("s_waitcnt vmcnt(0)" ::: "memory");
            }
            __syncthreads();
          }
          int* sitem = (int*)(smem + 73728 - 16);
          while (true) {
            __syncthreads();
            if (tid == 0) *sitem = (int)atomicAdd(&ctrs[b], 1u);
            __syncthreads();
            const int item = *sitem;
            if (item >= 256 + 128) break;
            if (item < 256) attn_item(p, b, item, smem);
            else { const int i = item - 256; gemm_tile<G_RWG>(p, b * 32 + (i >> 2), i & 3, 0, smem); }
          }
        }
      }
      if (stage == 0) xcd_barrier(xbar, (unsigned)X.cnt, 2u);
    }
  }
  xcd_barrier(xbar, (unsigned)X.cnt, 3u);
  FOR_BATCH(b) FOR_ITEMS(i, 1024) gn_item(p, b, i);
  xcd_barrier(xbar, (unsigned)X.cnt, 4u);
  FOR_BATCH(b) FOR_ITEMS(i0, 128 * PM(64)) { const int i = i0 & 127; gemm_tile<G_OUT, true>(p, b * 16 + (i >> 3), i & 7, 0, smem); }
  xcd_barrier(xbar, (unsigned)X.cnt, 5u);
  FOR_BATCH(b) FOR_ITEMS(i, 1024 * PM(128)) rmsnorm_rows(p.out, p.ln_ffn_g, (u16*)(p.ws + OFF_BUFA), b * 1024 + (i & 1023));
  xcd_barrier(xbar, (unsigned)X.cnt, 6u);
  for (int rep = 0; rep < ((DBL & 1) ? 2 : 1); ++rep)
  FOR_BATCH(b) FOR_ITEMS(i, 512) {
    const int tnh = i >> 7, tm = (i >> 3) & 15, tnl = i & 7;
    gemm_tile<G_FF1, true>(p, b * 16 + tm, tnh * 8 + tnl, 0, smem);
  }
  xcd_barrier(xbar, (unsigned)X.cnt, 7u);
  FOR_BATCH(b) FOR_ITEMS(i, 128) gemm_tile<G_FF2, true>(p, b * 16 + (i >> 3), i & 7, 0, smem);
}

extern "C" void kernel_launch(void* const* d_in, const int* in_sizes, int n_in, void* d_out, int out_size, void* d_ws, size_t ws_size,
                              hipStream_t stream) {
  static int grid_blocks = 0;
  if (!grid_blocks) {
    int dev = 0, cus = 0, per_cu = 0;
    hipGetDevice(&dev);
    hipDeviceGetAttribute(&cus, hipDeviceAttributeMultiprocessorCount, dev);
    hipOccupancyMaxActiveBlocksPerMultiprocessor(&per_cu, fwd_megakernel, 256, 0);
    if (per_cu > 2) per_cu = 2;
    if (per_cu < 1) per_cu = 1;
    grid_blocks = cus * per_cu;
  }
  Params p{};
  const float** f = (const float**)&p;
  for (int i = 0; i < 29; ++i) f[i] = (const float*)d_in[i];
  p.out = (float*)d_out;
  p.ws = (char*)d_ws;
  hipMemsetAsync((char*)d_ws + OFF_CTR, 0, 4096, stream);
  void* args[] = {&p};
  hipError_t e = hipLaunchCooperativeKernel((void*)fwd_megakernel, dim3(grid_blocks), dim3(256), args, 0, stream);
  if (e != hipSuccess) fprintf(stderr, "cooperative launch failed: %s (grid %d)\n", hipGetErrorString(e), grid_blocks);
}
```

```cpp
#include <hip/hip_runtime.h>
#include <hip/hip_cooperative_groups.h>
#include <stdint.h>
#include <stdio.h>
namespace cg = cooperative_groups;

typedef __attribute__((ext_vector_type(8))) short bf16x8;
typedef __attribute__((ext_vector_type(4))) short s16x4;
typedef __attribute__((ext_vector_type(16))) float f32x16;
typedef __attribute__((ext_vector_type(2))) float f32x2;
typedef __attribute__((ext_vector_type(2))) _Float16 bfx2;
typedef __attribute__((ext_vector_type(8))) _Float16 h16x8;
typedef unsigned short u16;
#define DI __device__ __forceinline__
#define MFMA(a, b, c) __builtin_amdgcn_mfma_f32_32x32x16_f16(__builtin_bit_cast(h16x8, (a)), __builtin_bit_cast(h16x8, (b)), (c), 0, 0, 0)

constexpr int Bz = 8, T = 4096, M = Bz * T, NP = 3200;
constexpr int KC_OFF = 512, VC_OFF = 640, KS_OFF = 768, VS_OFF = 896, KW_OFF = 1024, VW_OFF = 1152,
              R_OFF = 1280, K_OFF = 1792, V_OFF = 2304, XW_OFF = 2816, XA_OFF = 2880, XG_OFF = 2944, GL_OFF = 3072;
constexpr int NCMP_ROWS = 8 * 255 * 2;

constexpr size_t OFF_WTIN = 0;
constexpr size_t OFF_WTOUT = OFF_WTIN + (size_t)3200 * 1024 * 2;
constexpr size_t OFF_WTFF1 = OFF_WTOUT + (size_t)1024 * 1024 * 2;
constexpr size_t OFF_WTFF2 = OFF_WTFF1 + (size_t)4096 * 1024 * 2;
constexpr size_t OFF_CW1T = OFF_WTFF2 + (size_t)4096 * 1024 * 2;
constexpr size_t OFF_W2T = OFF_CW1T + (size_t)2 * 128 * 2048 * 2;
constexpr size_t OFF_A2T = OFF_W2T + (size_t)512 * 64 * 2;
constexpr size_t OFF_G2T = OFF_A2T + (size_t)512 * 64 * 2;
constexpr size_t OFF_PBIAS = OFF_G2T + (size_t)512 * 128 * 2;
constexpr size_t OFF_CTR = OFF_PBIAS + 1024;
constexpr size_t OFF_KCN = OFF_CTR + 4096;
constexpr size_t OFF_VCT = OFF_KCN + (size_t)8 * 2 * 256 * 64 * 2;
constexpr size_t OFF_VST = OFF_VCT + (size_t)8 * 2 * 256 * 64 * 2;
constexpr size_t OFF_VWT = OFF_VST + (size_t)8 * 2 * 64 * 4096 * 2;
constexpr size_t OFF_BUFA = OFF_VWT + (size_t)8 * 2 * 64 * 4096 * 2;
constexpr size_t OFF_PROJ = OFF_BUFA + (size_t)M * 1024 * 2;
constexpr size_t OFF_AA = OFF_PROJ + (size_t)M * NP * 2;
constexpr size_t OFF_MIX = OFF_AA + (size_t)M * 512 * 4;
constexpr size_t OFF_G = OFF_MIX + (size_t)M * 1024 * 2;
constexpr size_t OFF_T0 = OFF_G + (size_t)M * 512 * 2;
constexpr size_t OFF_PBP = OFF_T0 + 65536;
constexpr size_t OFF_BON = OFF_PBP + 65536;

struct Params {
  const float *x, *ln_mix_g, *w_in, *gate_b, *q_g, *kc_g, *ks_g, *kw_g;
  const float *ck_pos, *ck_w1, *ck_w2, *cv_pos, *cv_w1, *cv_w2;
  const float *mu, *w0, *w2, *a0, *a2, *g2, *k_k, *k_a, *r_k, *lnx_w, *lnx_b;
  const float *w_out, *ln_ffn_g, *w_ff1, *w_ff2;
  float* out;
  char* ws;
};

DI int launder(int x) { asm volatile("" : "+v"(x)); return x; }
DI float bf2f(u16 h) { return (float)__builtin_bit_cast(_Float16, h); }
DI unsigned pack2(float a, float b) { f32x2 v = {a, b}; bfx2 r = __builtin_convertvector(v, bfx2); return __builtin_bit_cast(unsigned, r); }
DI u16 f2bf(float a) { return (u16)(pack2(a, 0.f) & 0xffffu); }
DI float lo_bf(unsigned u) { bfx2 h = __builtin_bit_cast(bfx2, u); return (float)h[0]; }
DI float hi_bf(unsigned u) { bfx2 h = __builtin_bit_cast(bfx2, u); return (float)h[1]; }
DI float sigmoidf_(float x) { return 1.f / (1.f + __expf(-x)); }
DI float wave_sum(float v) {
  v += __shfl_xor(v, 32); v += __shfl_xor(v, 16); v += __shfl_xor(v, 8);
  v += __shfl_xor(v, 4); v += __shfl_xor(v, 2); v += __shfl_xor(v, 1);
  return v;
}
template <int CTRL> DI float dpp_f(float v) {
  return __builtin_bit_cast(float, __builtin_amdgcn_update_dpp(0, __builtin_bit_cast(int, v), CTRL, 0xF, 0xF, false));
}
DI float oct_sum(float v) { v += dpp_f<0xB1>(v); v += dpp_f<0x4E>(v); v += dpp_f<0x141>(v); return v; }
DI float quad_sum(float v) { v += dpp_f<0xB1>(v); v += dpp_f<0x4E>(v); return v; }
DI float row16_sum(float v) { v += dpp_f<0x128>(v); v += dpp_f<0x124>(v); v += dpp_f<0x122>(v); v += dpp_f<0x121>(v); return v; }

constexpr size_t PROJ_B = (size_t)T * NP * 2, AA_B = (size_t)T * 512 * 4, SLAB = PROJ_B + AA_B;
static_assert((size_t)T * 4096 * 2 <= SLAB, "hidden must fit its batch slab");
DI size_t prow(size_t m) { return m * NP + (m >> 12) * (AA_B / 2); }
DI float* aaptr(char* ws, size_t m) { return (float*)(ws + OFF_PROJ + (m >> 12) * SLAB + PROJ_B) + (m & 4095) * 512; }
DI size_t hid_off(int m, int c) { const int ml = m & 4095; return (size_t)(m >> 12) * (SLAB / 2) + ((size_t)((ml >> 8) * 128 + (c >> 5)) << 13) + (size_t)((ml & 255) * 32 + (c & 31)); }
DI int map_win(int nd) { return nd < 1280 ? nd : (nd < 3072 ? nd + 24 : (nd < 3096 ? nd - 3072 + 1280 : -1)); }

DI void transpose_tile(const float* __restrict__ src, int ldsrc, u16* __restrict__ dst, int Kd, int k0, int n0, bool mapped, char* smem) {
  float* s = (float*)smem;
  const int tid = threadIdx.x;
  __syncthreads();
  const int nn = tid & 63;
  const int nd = n0 + nn;
  const int sc = mapped ? map_win(nd) : nd;
#pragma unroll 4
  for (int i = 0; i < 16; ++i) {
    int k = (tid >> 6) + 4 * i;
    float v = (sc >= 0) ? src[(size_t)(k0 + k) * ldsrc + sc] : 0.f;
    s[k * 65 + nn] = v;
  }
  __syncthreads();
  const int n = tid >> 2, kc = (tid & 3) * 16;
  unsigned pk[8];
#pragma unroll
  for (int e = 0; e < 8; ++e) pk[e] = pack2(s[(kc + 2 * e) * 65 + n], s[(kc + 2 * e + 1) * 65 + n]);
  uint4* d = (uint4*)(dst + (size_t)(n0 + n) * Kd + k0 + kc);
  d[0] = make_uint4(pk[0], pk[1], pk[2], pk[3]);
  d[1] = make_uint4(pk[4], pk[5], pk[6], pk[7]);
  __syncthreads();
}

DI void rmsnorm_rows(const float* __restrict__ src, const float* __restrict__ g, u16* __restrict__ dst, int item) {
  const int lane = threadIdx.x & 63, w = threadIdx.x >> 6;
  const size_t row = (size_t)item * 4 + w;
  const float4* s4 = (const float4*)(src + row * 1024);
  float4 v[4];
  float ss = 0.f;
#pragma unroll
  for (int i = 0; i < 4; ++i) { v[i] = s4[lane + 64 * i]; ss += v[i].x * v[i].x + v[i].y * v[i].y + v[i].z * v[i].z + v[i].w * v[i].w; }
  ss = wave_sum(ss);
  const float sc = rsqrtf(ss * (1.f / 1024.f) + 1e-6f);
  const float4* g4 = (const float4*)g;
#pragma unroll
  for (int i = 0; i < 4; ++i) {
    float4 gg = g4[lane + 64 * i];
    uint2 o = make_uint2(pack2(v[i].x * sc * gg.x, v[i].y * sc * gg.y), pack2(v[i].z * sc * gg.z, v[i].w * sc * gg.w));
    *(uint2*)(dst + row * 1024 + (lane + 64 * i) * 4) = o;
  }
}

enum { G_INPROJ = 0, G_CMP, G_RWG, G_RWW, G_RWA, G_OUT, G_FF1, G_FF2 };

template <int MODE> DI constexpr int gemm_kt() {
  return MODE == G_INPROJ ? 16 : MODE == G_CMP ? 32 : MODE == G_RWG ? 2 : MODE == G_RWW ? 1 : MODE == G_RWA ? 1 : MODE == G_OUT ? 16 : MODE == G_FF1 ? 16 : 64;
}

template <int MODE> DI uint4 load_a(const Params& p, int tm, int kv, int row, int kt, int c) {
  const u16* proj = (const u16*)(p.ws + OFF_PROJ);
  if constexpr (MODE == G_INPROJ || MODE == G_FF1) {
    const u16* A = (const u16*)(p.ws + OFF_BUFA);
    return *(const uint4*)(A + (size_t)(tm * 128 + row) * 1024 + kt * 64 + c * 8);
  } else if constexpr (MODE == G_OUT) {
    const u16* A = (const u16*)(p.ws + OFF_MIX);
    return *(const uint4*)(A + (size_t)(tm * 128 + row) * 1024 + kt * 64 + c * 8);
  } else if constexpr (MODE == G_FF2) {
    const u16* A = (const u16*)(p.ws + OFF_PROJ);
    return *(const uint4*)(A + hid_off(tm * 128 + row, kt * 64 + c * 8));
  } else if constexpr (MODE == G_CMP) {
    const int b = tm >> 2; int rem = (tm & 3) * 128 + row; rem = rem < 510 ? rem : 509;
    const int i = rem >> 1, h = rem & 1;
    return *(const uint4*)(proj + prow((size_t)(b * T + 16 * i + kt)) + (kv ? VC_OFF : KC_OFF) + h * 64 + c * 8);
  } else {
    constexpr int OFFX = MODE == G_RWG ? XG_OFF : MODE == G_RWW ? XW_OFF : XA_OFF;
    const int m = tm * 128 + row;
    const int col = OFFX + kt * 64 + c * 8;
    const uint4 cur = *(const uint4*)(proj + prow(m) + col);
    uint4 prv = make_uint4(0, 0, 0, 0);
    if ((m & (T - 1)) != 0) prv = *(const uint4*)(proj + prow(m - 1) + col);
    const float4* mu4 = (const float4*)(p.mu + (col - 1280));
    const float4 m0 = mu4[0], m1 = mu4[1];
    const unsigned cu[4] = {cur.x, cur.y, cur.z, cur.w}, pu[4] = {prv.x, prv.y, prv.z, prv.w};
    const float mm[8] = {m0.x, m0.y, m0.z, m0.w, m1.x, m1.y, m1.z, m1.w};
    unsigned o[4];
#pragma unroll
    for (int e = 0; e < 4; ++e) {
      float c0 = lo_bf(cu[e]), c1 = hi_bf(cu[e]), p0 = lo_bf(pu[e]), p1 = hi_bf(pu[e]);
      float z0 = c0 + (p0 - c0) * mm[2 * e], z1 = c1 + (p1 - c1) * mm[2 * e + 1];
      if constexpr (MODE == G_RWG) { z0 = sigmoidf_(z0); z1 = sigmoidf_(z1); }
      if constexpr (MODE == G_RWW) { z0 = tanhf(z0); z1 = tanhf(z1); }
      o[e] = pack2(z0, z1);
    }
    return make_uint4(o[0], o[1], o[2], o[3]);
  }
}

template <int MODE> DI uint4 load_b(const Params& p, int tn, int kv, int row, int kt, int c) {
  if constexpr (MODE == G_INPROJ) return *(const uint4*)((const u16*)(p.ws + OFF_WTIN) + (size_t)(tn * 128 + row) * 1024 + kt * 64 + c * 8);
  else if constexpr (MODE == G_OUT) return *(const uint4*)((const u16*)(p.ws + OFF_WTOUT) + (size_t)(tn * 128 + row) * 1024 + kt * 64 + c * 8);
  else if constexpr (MODE == G_FF1) return *(const uint4*)((const u16*)(p.ws + OFF_WTFF1) + (size_t)(tn * 128 + row) * 1024 + kt * 64 + c * 8);
  else if constexpr (MODE == G_FF2) return *(const uint4*)((const u16*)(p.ws + OFF_WTFF2) + (size_t)(tn * 128 + row) * 4096 + kt * 64 + c * 8);
  else if constexpr (MODE == G_CMP) return *(const uint4*)((const u16*)(p.ws + OFF_CW1T) + (size_t)(kv * 128 + row) * 2048 + kt * 64 + c * 8);
  else if constexpr (MODE == G_RWG) return *(const uint4*)((const u16*)(p.ws + OFF_G2T) + (size_t)(tn * 128 + row) * 128 + kt * 64 + c * 8);
  else if constexpr (MODE == G_RWW) return *(const uint4*)((const u16*)(p.ws + OFF_W2T) + (size_t)(tn * 128 + row) * 64 + c * 8);
  else return *(const uint4*)((const u16*)(p.ws + OFF_A2T) + (size_t)(tn * 128 + row) * 64 + c * 8);
}

DI float gelu_tanh(float x) {
  const float u = 0.7978845608028654f * (x + 0.044715f * x * x * x);
  return 0.5f * x * (1.f + tanhf(u));
}

template <int MODE, bool BIG = false> DI void gemm_tile(const Params& p, int tm, int tn, int kv, char* smem) {
  constexpr int KT = gemm_kt<MODE>();
  constexpr int RB = BIG ? 256 : 128;
  constexpr int MT = BIG ? 4 : 2;
  const int tid = launder(threadIdx.x), lane = tid & 63, w = tid >> 6;
  const int r = lane & 31, hf = lane >> 5;
  const int wm = w >> 1, wn = w & 1;
  char* As = smem;
  char* Bs = smem + 128 * 144;
  float* Cs = (float*)smem;
  const int tma = BIG ? tm * 2 : tm;

  f32x16 acc[MT][2];
#pragma unroll
  for (int i = 0; i < MT; ++i)
#pragma unroll
    for (int j = 0; j < 2; ++j)
#pragma unroll
      for (int e = 0; e < 16; ++e) acc[i][j][e] = 0.f;

  if constexpr (!BIG) {
    uint4 ra[4], rb[4];
#pragma unroll
    for (int i = 0; i < 4; ++i) { const int id = tid + 256 * i; ra[i] = load_a<MODE>(p, tma, kv, id >> 3, 0, id & 7); rb[i] = load_b<MODE>(p, tn, kv, id >> 3, 0, id & 7); }
    for (int kt = 0; kt < KT; ++kt) {
      __syncthreads();
#pragma unroll
      for (int i = 0; i < 4; ++i) {
        const int id = tid + 256 * i;
        *(uint4*)(As + (id >> 3) * 144 + (id & 7) * 16) = ra[i];
        *(uint4*)(Bs + (id >> 3) * 144 + (id & 7) * 16) = rb[i];
      }
      __syncthreads();
      if (kt + 1 < KT) {
#pragma unroll
        for (int i = 0; i < 4; ++i) { const int id = tid + 256 * i; ra[i] = load_a<MODE>(p, tma, kv, id >> 3, kt + 1, id & 7); rb[i] = load_b<MODE>(p, tn, kv, id >> 3, kt + 1, id & 7); }
      }
#pragma unroll
      for (int s = 0; s < 4; ++s) {
        bf16x8 af[2], bfr[2];
#pragma unroll
        for (int i = 0; i < 2; ++i) af[i] = *(const bf16x8*)(As + (wm * 64 + i * 32 + r) * 144 + s * 32 + hf * 16);
#pragma unroll
        for (int j = 0; j < 2; ++j) bfr[j] = *(const bf16x8*)(Bs + (wn * 64 + j * 32 + r) * 144 + s * 32 + hf * 16);
#pragma unroll
        for (int i = 0; i < 2; ++i)
#pragma unroll
          for (int j = 0; j < 2; ++j) acc[i][j] = MFMA(af[i], bfr[j], acc[i][j]);
      }
    }
  } else {
    char* Bs2 = smem + 256 * 80;
    uint4 ra[4], rb[2];
#pragma unroll
    for (int i = 0; i < 4; ++i) { const int id = tid + 256 * i; ra[i] = load_a<MODE>(p, tma, kv, id >> 2, 0, id & 3); }
#pragma unroll
    for (int i = 0; i < 2; ++i) { const int id = tid + 256 * i; rb[i] = load_b<MODE>(p, tn, kv, id >> 2, 0, id & 3); }
    for (int kt = 0; kt < 2 * KT; ++kt) {
      __syncthreads();
#pragma unroll
      for (int i = 0; i < 4; ++i) { const int id = tid + 256 * i; *(uint4*)(As + (id >> 2) * 80 + (id & 3) * 16) = ra[i]; }
#pragma unroll
      for (int i = 0; i < 2; ++i) { const int id = tid + 256 * i; *(uint4*)(Bs2 + (id >> 2) * 80 + (id & 3) * 16) = rb[i]; }
      __syncthreads();
      if (kt + 1 < 2 * KT) {
        const int k1 = kt + 1;
#pragma unroll
        for (int i = 0; i < 4; ++i) { const int id = tid + 256 * i; ra[i] = load_a<MODE>(p, tma, kv, id >> 2, k1 >> 1, ((k1 & 1) << 2) | (id & 3)); }
#pragma unroll
        for (int i = 0; i < 2; ++i) { const int id = tid + 256 * i; rb[i] = load_b<MODE>(p, tn, kv, id >> 2, k1 >> 1, ((k1 & 1) << 2) | (id & 3)); }
      }
      {
        bf16x8 af[2][4], bfr[2][2];
#pragma unroll
        for (int s = 0; s < 2; ++s) {
#pragma unroll
          for (int i = 0; i < 4; ++i) af[s][i] = *(const bf16x8*)(As + (wm * 128 + i * 32 + r) * 80 + s * 32 + hf * 16);
#pragma unroll
          for (int j = 0; j < 2; ++j) bfr[s][j] = *(const bf16x8*)(Bs2 + (wn * 64 + j * 32 + r) * 80 + s * 32 + hf * 16);
        }
        __builtin_amdgcn_s_setprio(1);
#pragma unroll
        for (int s = 0; s < 2; ++s)
#pragma unroll
          for (int i = 0; i < 4; ++i)
#pragma unroll
            for (int j = 0; j < 2; ++j) acc[i][j] = MFMA(af[s][i], bfr[s][j], acc[i][j]);
        __builtin_amdgcn_s_setprio(0);
      }
    }
  }
#pragma unroll 1
  for (int hh = 0; hh < (BIG ? 2 : 1); ++hh) {
  __syncthreads();
  if (!BIG || wm == hh) {
#pragma unroll
    for (int i = 0; i < MT; ++i)
#pragma unroll
      for (int j = 0; j < 2; ++j)
#pragma unroll
        for (int e = 0; e < 16; ++e) {
          const int row = (BIG ? 0 : wm * 64) + i * 32 + 8 * (e >> 2) + 4 * hf + (e & 3);
          const int col = wn * 64 + j * 32 + r;
          Cs[row * 132 + col] = acc[i][j][e];
        }
  }
  __syncthreads();

  const int row = tid >> 1, half = tid & 1;
  float* crow = Cs + row * 132 + half * 64;
  const float4* crow4 = (const float4*)crow;
  const int m = tm * RB + hh * 128 + row;
  const int col0 = tn * 128 + half * 64;

  if constexpr (MODE == G_INPROJ) {
    u16* proj = (u16*)(p.ws + OFF_PROJ);
    const int region = col0 >> 6;
    const float* g = nullptr; float extra = 1.f;
    if (region < 8) { g = p.q_g; extra = 0.125f; }
    else if (region == 12 || region == 13) g = p.ks_g;
    else if (region == 16 || region == 17) g = p.kw_g;
    float sc = 1.f;
    if (g) {
      float ss = 0.f;
#pragma unroll
      for (int c4 = 0; c4 < 16; ++c4) { float4 v = crow4[c4]; ss += v.x * v.x + v.y * v.y + v.z * v.z + v.w * v.w; }
      sc = rsqrtf(ss * (1.f / 64.f) + 1e-6f) * extra;
    }
#pragma unroll
    for (int c8 = 0; c8 < 8; ++c8) {
      float4 v0 = crow4[2 * c8], v1 = crow4[2 * c8 + 1];
      float v[8] = {v0.x, v0.y, v0.z, v0.w, v1.x, v1.y, v1.z, v1.w};
      if (g) {
#pragma unroll
        for (int e = 0; e < 8; ++e) v[e] = v[e] * sc * g[c8 * 8 + e];
      } else if (region == 48) {
#pragma unroll
        for (int e = 0; e < 8; ++e) { int c = c8 * 8 + e; v[e] = c < 24 ? sigmoidf_(v[e] + p.gate_b[c]) : 0.f; }
      }
      *(uint4*)(proj + prow(m) + col0 + c8 * 8) = make_uint4(pack2(v[0], v[1]), pack2(v[2], v[3]), pack2(v[4], v[5]), pack2(v[6], v[7]));
    }
  } else if constexpr (MODE == G_OUT) {
    const float4* x4 = (const float4*)(p.x + (size_t)m * 1024 + col0);
    float4* o4 = (float4*)(p.out + (size_t)m * 1024 + col0);
#pragma unroll
    for (int c4 = 0; c4 < 16; ++c4) { float4 v = crow4[c4], xx = x4[c4]; o4[c4] = make_float4(v.x + xx.x, v.y + xx.y, v.z + xx.z, v.w + xx.w); }
  } else if constexpr (MODE == G_FF2) {
    float4* o4 = (float4*)(p.out + (size_t)m * 1024 + col0);
#pragma unroll
    for (int c4 = 0; c4 < 16; ++c4) { float4 v = crow4[c4], xx = o4[c4]; o4[c4] = make_float4(v.x + xx.x, v.y + xx.y, v.z + xx.z, v.w + xx.w); }
  } else if constexpr (MODE == G_FF1) {
    u16* hid = (u16*)(p.ws + OFF_PROJ);
#pragma unroll
    for (int c8 = 0; c8 < 8; ++c8) {
      float4 v0 = crow4[2 * c8], v1 = crow4[2 * c8 + 1];
      float v[8] = {v0.x, v0.y, v0.z, v0.w, v1.x, v1.y, v1.z, v1.w};
#pragma unroll
      for (int e = 0; e < 8; ++e) { float t = fmaxf(v[e], 0.f); v[e] = t * t; }
      *(uint4*)(hid + hid_off(m, col0 + c8 * 8)) = make_uint4(pack2(v[0], v[1]), pack2(v[2], v[3]), pack2(v[4], v[5]), pack2(v[6], v[7]));
    }
  } else if constexpr (MODE == G_RWG) {
    u16* gb = (u16*)(p.ws + OFF_G);
#pragma unroll
    for (int c8 = 0; c8 < 8; ++c8) {
      float4 v0 = crow4[2 * c8], v1 = crow4[2 * c8 + 1];
      *(uint4*)(gb + (size_t)m * 512 + col0 + c8 * 8) = make_uint4(pack2(v0.x, v0.y), pack2(v0.z, v0.w), pack2(v1.x, v1.y), pack2(v1.z, v1.w));
    }
  } else if constexpr (MODE == G_RWW) {
    float4* W4 = (float4*)((float*)(p.ws + OFF_BUFA) + (size_t)m * 512 + col0);
    const float4* w04 = (const float4*)(p.w0 + col0);
#pragma unroll
    for (int c4 = 0; c4 < 16; ++c4) {
      float4 v = crow4[c4], ww = w04[c4];
      float u[4] = {v.x + ww.x, v.y + ww.y, v.z + ww.z, v.w + ww.w};
#pragma unroll
      for (int e = 0; e < 4; ++e) {
        const float z = -u[e];
        const float sp = fmaxf(z, 0.f) + log1pf(__expf(-fabsf(z)));
        u[e] = __expf(-__expf(-sp - 0.5f));
      }
      W4[c4] = make_float4(u[0], u[1], u[2], u[3]);
    }
  } else if constexpr (MODE == G_RWA) {
    const u16* proj = (const u16*)(p.ws + OFF_PROJ);
    float* prm = (float*)(smem + 128 * 132 * 4);
    if (tid < 128) {
      const int c = tn * 128 + tid;
      prm[tid] = p.mu[512 + c]; prm[128 + tid] = p.k_k[c]; prm[256 + tid] = p.a0[c]; prm[384 + tid] = p.k_a[c];
    }
    __syncthreads();
    const float* pmu = prm + half * 64; const float* pkk = prm + 128 + half * 64;
    const float* pa0 = prm + 256 + half * 64; const float* pka = prm + 384 + half * 64;
    float* AA = aaptr(p.ws, m) + col0;
    float* KP = p.out + (size_t)(m >> 12) * (4096 * 1024) + (size_t)(m & 4095) * 512 + col0;
    float* KK = KP + (size_t)4096 * 512;
    const bool has_prev = (m & (T - 1)) != 0;
    const u16* pc = proj + prow(m) + K_OFF + col0;
    const u16* pp = proj + prow(m - 1) + K_OFF + col0;
    float ss = 0.f;
#pragma unroll 2
    for (int c8 = 0; c8 < 8; ++c8) {
      uint4 cu = *(const uint4*)(pc + c8 * 8);
      uint4 pu = has_prev ? *(const uint4*)(pp + c8 * 8) : make_uint4(0, 0, 0, 0);
      const unsigned cw[4] = {cu.x, cu.y, cu.z, cu.w}, pw[4] = {pu.x, pu.y, pu.z, pu.w};
#pragma unroll
      for (int e = 0; e < 8; ++e) {
        const int c = c8 * 8 + e;
        const float cc = (e & 1) ? hi_bf(cw[e >> 1]) : lo_bf(cw[e >> 1]);
        const float pv = (e & 1) ? hi_bf(pw[e >> 1]) : lo_bf(pw[e >> 1]);
        const float k = cc + (pv - cc) * pmu[c];
        const float kkv = k * pkk[c];
        ss += kkv * kkv;
      }
    }
    const float inv = rsqrtf(fmaxf(ss, 1e-24f));
#pragma unroll 2
    for (int c8 = 0; c8 < 8; ++c8) {
      uint4 cu = *(const uint4*)(pc + c8 * 8);
      uint4 pu = has_prev ? *(const uint4*)(pp + c8 * 8) : make_uint4(0, 0, 0, 0);
      const unsigned cw[4] = {cu.x, cu.y, cu.z, cu.w}, pw[4] = {pu.x, pu.y, pu.z, pu.w};
      float4 v0 = crow4[2 * c8], v1 = crow4[2 * c8 + 1];
      const float av[8] = {v0.x, v0.y, v0.z, v0.w, v1.x, v1.y, v1.z, v1.w};
      float ao[8], kpo[8], kko[8];
#pragma unroll
      for (int e = 0; e < 8; ++e) {
        const int c = c8 * 8 + e;
        const float cc = (e & 1) ? hi_bf(cw[e >> 1]) : lo_bf(cw[e >> 1]);
        const float pv = (e & 1) ? hi_bf(pw[e >> 1]) : lo_bf(pw[e >> 1]);
        const float k = cc + (pv - cc) * pmu[c];
        const float a = sigmoidf_(pa0[c] + av[e]);
        ao[e] = a;
        kko[e] = k * pkk[c] * inv;
        kpo[e] = k * (1.f + (a - 1.f) * pka[c]);
      }
      *(float4*)(AA + c8 * 8) = make_float4(ao[0], ao[1], ao[2], ao[3]);
      *(float4*)(AA + c8 * 8 + 4) = make_float4(ao[4], ao[5], ao[6], ao[7]);
      *(float4*)(KP + c8 * 8) = make_float4(kpo[0], kpo[1], kpo[2], kpo[3]);
      *(float4*)(KP + c8 * 8 + 4) = make_float4(kpo[4], kpo[5], kpo[6], kpo[7]);
      *(float4*)(KK + c8 * 8) = make_float4(kko[0], kko[1], kko[2], kko[3]);
      *(float4*)(KK + c8 * 8 + 4) = make_float4(kko[4], kko[5], kko[6], kko[7]);
    }
  } else if constexpr (MODE == G_CMP) {
    float* pbl = (float*)(smem + 128 * 132 * 4);
    if (tid < 128) {
      const float* pp = (const float*)(p.ws + OFF_PBP) + kv * 32 * 128 + tid;
      float a = 0.f;
#pragma unroll 8
      for (int c = 0; c < 32; ++c) a += pp[c * 128];
      pbl[tid] = a;
    }
    __syncthreads();
    const float* pb = pbl + half * 64;
#pragma unroll
    for (int c4 = 0; c4 < 16; ++c4) {
      float4 v = crow4[c4];
      v.x = gelu_tanh(v.x + pb[c4 * 4 + 0]); v.y = gelu_tanh(v.y + pb[c4 * 4 + 1]);
      v.z = gelu_tanh(v.z + pb[c4 * 4 + 2]); v.w = gelu_tanh(v.w + pb[c4 * 4 + 3]);
      ((float4*)crow)[c4] = v;
    }
    __syncthreads();
    const float* w2 = kv ? p.cv_w2 : p.ck_w2;
    float w2c[64];
#pragma unroll
    for (int j = 0; j < 64; ++j) w2c[j] = w2[j * 64 + lane];
    for (int rr = 0; rr < 32; ++rr) {
      const int lrow = w * 32 + rr;
      const float4* h4 = (const float4*)(Cs + lrow * 132);
      float a = 0.f;
#pragma unroll
      for (int j4 = 0; j4 < 16; ++j4) {
        float4 hv = h4[j4];
        a += hv.x * w2c[4 * j4] + hv.y * w2c[4 * j4 + 1] + hv.z * w2c[4 * j4 + 2] + hv.w * w2c[4 * j4 + 3];
      }
      Cs[lrow * 132 + lane] = a;
    }
#pragma unroll
    for (int j = 0; j < 64; ++j) w2c[j] = w2[(64 + j) * 64 + lane];
    const float gk = p.kc_g[lane];
    u16* kcn = (u16*)(p.ws + OFF_KCN);
    u16* vct = (u16*)(p.ws + OFF_VCT);
    for (int rr = 0; rr < 32; ++rr) {
      const int lrow = w * 32 + rr;
      const float4* h4 = (const float4*)(Cs + lrow * 132 + 64);
      float a = Cs[lrow * 132 + lane];
#pragma unroll
      for (int j4 = 0; j4 < 16; ++j4) {
        float4 hv = h4[j4];
        a += hv.x * w2c[4 * j4] + hv.y * w2c[4 * j4 + 1] + hv.z * w2c[4 * j4 + 2] + hv.w * w2c[4 * j4 + 3];
      }
      const int rem = (tm & 3) * 128 + lrow;
      const float ss = wave_sum(a * a);
      if (rem < 510) {
        const int b = tm >> 2; const int i = rem >> 1, h = rem & 1;
        if (kv == 0) kcn[((size_t)(b * 2 + h) * 256 + i) * 64 + lane] = f2bf(a * rsqrtf(ss * (1.f / 64.f) + 1e-6f) * gk);
        else vct[((size_t)(b * 2 + h) * 64 + lane) * 256 + i] = f2bf(a);
      }
    }
  }
  }
}

DI void vtrans_item(const Params& p, int item, char* smem) {
  const int tb = item & 63, h = (item >> 6) & 1, b = (item >> 7) & 7, which = item >> 10;
  const u16* proj = (const u16*)(p.ws + OFF_PROJ);
  u16* dst = (u16*)(p.ws + (which ? OFF_VWT : OFF_VST)) + (size_t)(b * 2 + h) * 64 * T;
  const int off = (which ? VW_OFF : VS_OFF) + h * 64;
  u16* s = (u16*)smem;
  const int tid = threadIdx.x;
  __syncthreads();
#pragma unroll
  for (int i = 0; i < 2; ++i) {
    const int id = tid + 256 * i; const int t = id >> 3, c = id & 7;
    uint4 v = *(const uint4*)(proj + prow((size_t)(b * T + tb * 64 + t)) + off + c * 8);
    unsigned* sp = (unsigned*)(s + t * 66 + c * 8);
    sp[0] = v.x; sp[1] = v.y; sp[2] = v.z; sp[3] = v.w;
  }
  __syncthreads();
  const int d = tid >> 2, tc = (tid & 3) * 16;
  unsigned pk[8];
#pragma unroll
  for (int e = 0; e < 8; ++e) pk[e] = (unsigned)s[(tc + 2 * e) * 66 + d] | ((unsigned)s[(tc + 2 * e + 1) * 66 + d] << 16);
  uint4* o = (uint4*)(dst + (size_t)d * T + tb * 64 + tc);
  o[0] = make_uint4(pk[0], pk[1], pk[2], pk[3]);
  o[1] = make_uint4(pk[4], pk[5], pk[6], pk[7]);
  __syncthreads();
}

constexpr float L2E = 1.4426950408889634f;
constexpr float NEGB = -1e30f;
constexpr int A_KS = 0;
constexpr int A_VT = 64 * 144;
constexpr int A_IMP = 2 * 64 * 144;
constexpr int A_SEL = A_IMP + 32 * 68 * 4;
constexpr int A_JL = A_SEL + 32 * 8 + 16;
constexpr int A_OUT = A_JL + 64;
constexpr int A_END = A_OUT + 4 * 32 * 144;
static_assert(A_END <= 73728 - 16, "lds");

struct TileRegs { uint4 k0, k1, v0, v1; };
DI TileRegs tile_issue(const u16* kp, size_t kld, const u16* vp, size_t vld) {
  const int tid = launder(threadIdx.x);
  TileRegs tr;
  tr.k0 = *(const uint4*)(kp + (size_t)(tid >> 3) * kld + (tid & 7) * 8);
  tr.k1 = *(const uint4*)(kp + (size_t)((tid >> 3) + 32) * kld + (tid & 7) * 8);
  tr.v0 = *(const uint4*)(vp + (size_t)(tid >> 3) * vld + (tid & 7) * 8);
  tr.v1 = *(const uint4*)(vp + (size_t)((tid >> 3) + 32) * vld + (tid & 7) * 8);
  return tr;
}
DI void tile_commit(const TileRegs tr, char* smem) {
  const int tid = launder(threadIdx.x);
  *(uint4*)(smem + A_KS + (tid >> 3) * 144 + (tid & 7) * 16) = tr.k0;
  *(uint4*)(smem + A_KS + ((tid >> 3) + 32) * 144 + (tid & 7) * 16) = tr.k1;
  *(uint4*)(smem + A_VT + (tid >> 3) * 144 + (tid & 7) * 16) = tr.v0;
  *(uint4*)(smem + A_VT + ((tid >> 3) + 32) * 144 + (tid & 7) * 16) = tr.v1;
}

template <class PF, class CF> DI void run_tiles(char* smem, int n, PF issue_i, CF comp) {
  TileRegs ta = issue_i(0);
  TileRegs tb = issue_i(n > 1 ? 1 : 0);
  for (int i = 0; i < n; i += 2) {
    __syncthreads();
    tile_commit(ta, smem);
    __syncthreads();
    if (i + 2 < n) ta = issue_i(i + 2);
    comp(i);
    if (i + 1 >= n) break;
    __syncthreads();
    tile_commit(tb, smem);
    __syncthreads();
    if (i + 3 < n) tb = issue_i(i + 3);
    comp(i + 1);
  }
}

DI constexpr int kappa(int it, int e) { return it * 32 + 8 * (e >> 2) + (e & 3); }

struct BiasC { float sq1, sq2, sq3, sg[8]; };
DI float sgpr_f(float x) { return __int_as_float(__builtin_amdgcn_readfirstlane(__float_as_int(x))); }
DI float pow2_scale(float c, int k) { return c == 0.f ? 0.f : __int_as_float(__float_as_int(c) - (k << 23)); }
template <int KS> DI BiasC make_bias(int k) {
  BiasC c;
  c.sq1 = pow2_scale((float)KS, k); c.sq2 = pow2_scale(2.f * KS, k); c.sq3 = pow2_scale(3.f * KS, k);
#pragma unroll
  for (int i = 0; i < 8; ++i) c.sg[i] = pow2_scale((float)(KS * (32 * (i >> 2) + 8 * (i & 3))), k);
  return c;
}
DI void qk_scores(const char* Ks, const bf16x8 (&qf)[4], f32x16 (&S)[2], float bbase, const BiasC& bc, int lane) {
  lane = launder(lane);
  const int r = lane & 31, hf = lane >> 5;
#pragma unroll
  for (int it = 0; it < 2; ++it)
#pragma unroll
    for (int a = 0; a < 4; ++a) {
      const float base = bbase + bc.sg[it * 4 + a];
      S[it][4 * a] = base; S[it][4 * a + 1] = base + bc.sq1; S[it][4 * a + 2] = base + bc.sq2; S[it][4 * a + 3] = base + bc.sq3;
    }
#pragma unroll
  for (int s = 0; s < 4; ++s)
#pragma unroll
    for (int it = 0; it < 2; ++it) {
      const bf16x8 kf = *(const bf16x8*)(Ks + (it * 32 + r) * 144 + s * 32 + hf * 16);
      S[it] = MFMA(kf, qf[s], S[it]);
    }
}

template <int KS, int MASK> DI bool valid_d(int delta, int it, int e) {
  const int d = delta - KS * kappa(it, e);
  if constexpr (MASK == 1) return d >= 0;
  if constexpr (MASK == 2) return d < 512;
  return true;
}

template <int KS, int MASK>
DI float softmax_step(f32x16 (&S)[2], int delta, float& mrun, float& lrun) {
  float mx = mrun;
#pragma unroll
  for (int it = 0; it < 2; ++it)
#pragma unroll
    for (int e = 0; e < 16; ++e) {
      if constexpr (MASK != 0) S[it][e] = valid_d<KS, MASK>(delta, it, e) ? S[it][e] : NEGB;
      mx = fmaxf(mx, S[it][e]);
    }
  mx = fmaxf(mx, __shfl_xor(mx, 32));
  const float alpha = __builtin_amdgcn_exp2f((mrun - mx) * L2E);
  mrun = mx;
  const float mxs = mx * L2E;
  float ls = 0.f;
#pragma unroll
  for (int it = 0; it < 2; ++it)
#pragma unroll
    for (int e = 0; e < 16; ++e) {
      float pe = __builtin_amdgcn_exp2f(fmaf(S[it][e], L2E, -mxs));
      if constexpr (MASK != 0) pe = valid_d<KS, MASK>(delta, it, e) ? pe : 0.f;
      S[it][e] = pe;
      ls += pe;
    }
  lrun = lrun * alpha + ls;
  return alpha;
}

DI bf16x8 pack8(const f32x16& x, int s2) {
  unsigned a = pack2(x[8 * s2 + 0], x[8 * s2 + 1]), b = pack2(x[8 * s2 + 2], x[8 * s2 + 3]);
  unsigned c = pack2(x[8 * s2 + 4], x[8 * s2 + 5]), d = pack2(x[8 * s2 + 6], x[8 * s2 + 7]);
  uint4 u = make_uint4(a, b, c, d);
  return __builtin_bit_cast(bf16x8, u);
}

DI void pv_accum(const char* VTs, const f32x16 (&P)[2], f32x16 (&O)[2], int lane) {
  lane = launder(lane);
  const int r = lane & 31, hf = lane >> 5;
#pragma unroll
  for (int it = 0; it < 2; ++it)
#pragma unroll
    for (int s2 = 0; s2 < 2; ++s2) {
      const bf16x8 pf = pack8(P[it], s2);
#pragma unroll
      for (int dt = 0; dt < 2; ++dt) {
        const char* ptr = VTs + (dt * 32 + r) * 144 + (it * 32 + 16 * s2 + 4 * hf) * 2;
        const s16x4 lo = *(const s16x4*)ptr;
        const s16x4 hi = *(const s16x4*)(ptr + 16);
        const bf16x8 vf = __builtin_shufflevector(lo, hi, 0, 1, 2, 3, 4, 5, 6, 7);
        O[dt] = MFMA(vf, pf, O[dt]);
      }
    }
}

DI void zero_tiles(f32x16 (&O)[2]) {
#pragma unroll
  for (int a = 0; a < 2; ++a)
#pragma unroll
    for (int e = 0; e < 16; ++e) O[a][e] = 0.f;
}

template <bool FIRST>
DI void out_accum(char* outw, const f32x16 (&O)[2], float scale, int lane) {
  lane = launder(lane);
  const int r = lane & 31, hf = lane >> 5;
#pragma unroll
  for (int dt = 0; dt < 2; ++dt)
#pragma unroll
    for (int a = 0; a < 4; ++a) {
      uint2* ptr = (uint2*)(outw + r * 144 + (dt * 32 + 8 * a + 4 * hf) * 2);
      float v0 = O[dt][4 * a] * scale, v1 = O[dt][4 * a + 1] * scale;
      float v2 = O[dt][4 * a + 2] * scale, v3 = O[dt][4 * a + 3] * scale;
      if constexpr (!FIRST) {
        const uint2 old = *ptr;
        v0 += lo_bf(old.x); v1 += hi_bf(old.x); v2 += lo_bf(old.y); v3 += hi_bf(old.y);
      }
      *ptr = make_uint2(pack2(v0, v1), pack2(v2, v3));
    }
}

DI void cmp_probs(f32x16 (&S)[2], int delta, float mfin, float invl) {
  const float mxs = mfin * L2E;
#pragma unroll
  for (int it = 0; it < 2; ++it)
#pragma unroll
    for (int e = 0; e < 16; ++e) {
      const float pe = __builtin_amdgcn_exp2f(fmaf(S[it][e], L2E, -mxs)) * invl;
      S[it][e] = valid_d<16, 1>(delta, it, e) ? pe : 0.f;
    }
}

DI void attn_item(const Params& p, int b, int item, char* smem) {
  const int qh = 127 - (item >> 1);
  const int qb = qh >> 1;
  const int h = item & 1;
  const int tid = threadIdx.x, lane = tid & 63;
  const int g = __builtin_amdgcn_readfirstlane(tid >> 6);
  const int r = lane & 31, hf = lane >> 5;
  const int head = h * 4 + g;
  const float slope = sgpr_f(__builtin_amdgcn_exp2f(-(float)(head + 1)));
  const BiasC bc1 = make_bias<1>(head + 1), bc16 = make_bias<16>(head + 1);
  const u16* proj = (const u16*)(p.ws + OFF_PROJ);
  const int q0 = qh * 32;
  const size_t m0 = (size_t)b * T + (size_t)q0;
  const int tq = q0 + r;
  char* Ks = smem + A_KS;
  char* VTs = smem + A_VT;
  float* IMPs = (float*)(smem + A_IMP);
  unsigned long long* SELM = (unsigned long long*)(smem + A_SEL);
  unsigned* UN = (unsigned*)(smem + A_SEL + 32 * 8);
  char* outw = smem + A_OUT + g * 32 * 144;

  bf16x8 qf[4];
  float gate[3];
  {
    const u16* qrow = proj + prow(m0 + r);
#pragma unroll
    for (int s = 0; s < 4; ++s) qf[s] = *(const bf16x8*)(qrow + head * 64 + s * 16 + hf * 8);
#pragma unroll
    for (int br = 0; br < 3; ++br) gate[br] = bf2f(qrow[GL_OFF + head * 3 + br]);
  }
  if (tid < 2) UN[tid] = 0;

  f32x16 S[2], O[2];
  float mrun, lrun;

  const int nkt = ((q0 >> 4) + 1 + 63) >> 6;
  const u16* kc = (const u16*)(p.ws + OFF_KCN) + (size_t)(b * 2 + h) * 256 * 64;
  const u16* vc = (const u16*)(p.ws + OFF_VCT) + (size_t)(b * 2 + h) * 64 * 256;
  mrun = NEGB; lrun = 0.f;
  auto cmp_issue = [&](int kt) { return tile_issue(kc + (size_t)kt * 64 * 64, 64, vc + kt * 64, 256); };
  run_tiles(smem, nkt, cmp_issue, [&](int kt) {
    const int delta = tq - 31 - 1024 * kt - 64 * hf;
    qk_scores(Ks, qf, S, -slope * (float)delta, bc16, lane);
    softmax_step<16, 1>(S, delta, mrun, lrun);
  });
  float invl, mfin;
  {
    const float lt = lrun + __shfl_xor(lrun, 32);
    invl = lt > 0.f ? 1.f / lt : 0.f;
    mfin = mrun;
  }
  zero_tiles(O);
  run_tiles(smem, nkt, cmp_issue, [&](int kt) {
    const int delta = tq - 31 - 1024 * kt - 64 * hf;
    qk_scores(Ks, qf, S, -slope * (float)delta, bc16, lane);
    cmp_probs(S, delta, mfin, invl);
    pv_accum(VTs, S, O, lane);
  });
  out_accum<true>(outw, O, gate[0], lane);
  zero_tiles(O);
  run_tiles(smem, nkt, cmp_issue, [&](int kt) {
    const int delta = tq - 31 - 1024 * kt - 64 * hf;
    qk_scores(Ks, qf, S, -slope * (float)delta, bc16, lane);
    cmp_probs(S, delta, mfin, invl);
#pragma unroll
    for (int it = 0; it < 2; ++it)
#pragma unroll
      for (int s2 = 0; s2 < 2; ++s2) {
        const bf16x8 pf = pack8(S[it], s2);
#pragma unroll
        for (int dt = 0; dt < 2; ++dt) {
          const int j = dt * 32 + r;
          bf16x8 ov;
          const int nb0 = 64 * kt + 4 * hf - 4 * j + 1;
#pragma unroll
          for (int e = 0; e < 8; ++e) {
            const unsigned dn = (unsigned)(nb0 + it * 32 + 16 * s2 + 8 * (e >> 2) + (e & 3));
            ov[e] = (dn <= 4u) ? (short)0x3C00 : (short)0;
          }
          O[dt] = MFMA(ov, pf, O[dt]);
        }
      }
  });
  for (int round = 0; round < 4; ++round) {
    __syncthreads();
    if (g == round) {
#pragma unroll
      for (int dt = 0; dt < 2; ++dt)
#pragma unroll
        for (int a = 0; a < 4; ++a) {
          float4* ptr = (float4*)(IMPs + r * 68 + dt * 32 + 8 * a + 4 * hf);
          float4 v = make_float4(O[dt][4 * a], O[dt][4 * a + 1], O[dt][4 * a + 2], O[dt][4 * a + 3]);
          if (round != 0) { const float4 o = *ptr; v.x += o.x; v.y += o.y; v.z += o.z; v.w += o.w; }
          *ptr = v;
        }
    }
  }
  __syncthreads();
  {
    const int t = tid >> 3, j0 = (tid & 7) * 8;
#pragma unroll
    for (int e = 0; e < 8; ++e) {
      const int j = j0 + e;
      float v = IMPs[t * 68 + j];
      const bool forced = (j == 0) || (j == qb) || (j == qb - 1);
      v = forced ? 1e6f : (j > qb ? NEGB : v);
      IMPs[t * 68 + j] = v;
    }
  }
  __syncthreads();
  for (int i = 0; i < 8; ++i) {
    const int t = g * 8 + i;
    const float vj = IMPs[t * 68 + lane];
    int rank = 0;
#pragma unroll 1
    for (int c4 = 0; c4 < 16; ++c4) {
      const float4 v = *(const float4*)(IMPs + t * 68 + c4 * 4);
      const int rel = lane - c4 * 4;
      rank += (v.x > vj || (v.x == vj && 0 < rel)) ? 1 : 0;
      rank += (v.y > vj || (v.y == vj && 1 < rel)) ? 1 : 0;
      rank += (v.z > vj || (v.z == vj && 2 < rel)) ? 1 : 0;
      rank += (v.w > vj || (v.w == vj && 3 < rel)) ? 1 : 0;
    }
    const unsigned long long msk = __ballot(rank < 16);
    if (lane == 0) {
      SELM[t] = msk;
      atomicOr(&UN[0], (unsigned)(msk & 0xffffffffull));
      atomicOr(&UN[1], (unsigned)(msk >> 32));
    }
  }
  __syncthreads();
  const unsigned long long selm = SELM[r];
  unsigned long long un;
  {
    unsigned u0 = __builtin_amdgcn_readfirstlane(UN[0]), u1 = __builtin_amdgcn_readfirstlane(UN[1]);
    un = (unsigned long long)u0 | ((unsigned long long)u1 << 32);
    un &= (qb == 63) ? ~0ull : ((1ull << (qb + 1)) - 1ull);
  }

  {
    unsigned char* JL = (unsigned char*)(smem + A_JL);
    if (tid < 64 && ((un >> tid) & 1ull)) JL[__builtin_popcountll(tid == 63 ? 0ull : (un >> (tid + 1)))] = (unsigned char)tid;
    const int nsel = __builtin_popcountll(un);
    __syncthreads();
    const u16* ksb = proj + prow((size_t)b * T) + KS_OFF + h * 64;
    const u16* vsb = (const u16*)(p.ws + OFF_VST) + (size_t)(b * 2 + h) * 64 * T;
    mrun = NEGB; lrun = 0.f;
    zero_tiles(O);
    run_tiles(smem, nsel,
      [&](int i) { const int j = JL[i]; return tile_issue(ksb + (size_t)j * 64 * NP, NP, vsb + j * 64, T); },
      [&](int i) {
        const int j = __builtin_amdgcn_readfirstlane((int)JL[i]);
        const int delta = tq - j * 64 - 4 * hf;
        const bool sel = (selm >> j) & 1ull;
        qk_scores(Ks, qf, S, sel ? -slope * (float)delta : NEGB, bc1, lane);
        float alpha;
        if (j == qb) alpha = softmax_step<1, 1>(S, delta, mrun, lrun);
        else alpha = softmax_step<1, 0>(S, delta, mrun, lrun);
        if (__builtin_amdgcn_ballot_w64(alpha != 1.f) != 0ull) {
#pragma unroll
          for (int dt = 0; dt < 2; ++dt)
#pragma unroll
            for (int e = 0; e < 16; ++e) O[dt][e] *= alpha;
        }
        pv_accum(VTs, S, O, lane);
      });
    const float lt = lrun + __shfl_xor(lrun, 32);
    out_accum<false>(outw, O, lt > 0.f ? gate[1] / lt : 0.f, lane);
  }
  {
    const u16* kwb = proj + prow((size_t)b * T) + KW_OFF + h * 64;
    const u16* vwb = (const u16*)(p.ws + OFF_VWT) + (size_t)(b * 2 + h) * 64 * T;
    mrun = NEGB; lrun = 0.f;
    zero_tiles(O);
    const int jlo = qb - 8 > 0 ? qb - 8 : 0;
    run_tiles(smem, qb - jlo + 1,
      [&](int i) { const int j = qb - i; return tile_issue(kwb + (size_t)j * 64 * NP, NP, vwb + j * 64, T); },
      [&](int i) {
        const int j = qb - i;
        const int delta = tq - j * 64 - 4 * hf;
        qk_scores(Ks, qf, S, -slope * (float)delta, bc1, lane);
        float alpha;
        if (j == qb) alpha = softmax_step<1, 1>(S, delta, mrun, lrun);
        else if (j == qb - 8) alpha = softmax_step<1, 2>(S, delta, mrun, lrun);
        else alpha = softmax_step<1, 0>(S, delta, mrun, lrun);
        if (__builtin_amdgcn_ballot_w64(alpha != 1.f) != 0ull) {
#pragma unroll
          for (int dt = 0; dt < 2; ++dt)
#pragma unroll
            for (int e = 0; e < 16; ++e) O[dt][e] *= alpha;
        }
        pv_accum(VTs, S, O, lane);
      });
    const float lt = lrun + __shfl_xor(lrun, 32);
    out_accum<false>(outw, O, lt > 0.f ? gate[2] / lt : 0.f, lane);
  }
  __syncthreads();
  {
    u16* mix = (u16*)(p.ws + OFF_MIX);
#pragma unroll
    for (int i = 0; i < 4; ++i) {
      const int t = (lane >> 3) + 8 * i, c = lane & 7;
      const uint4 v = *(const uint4*)(outw + t * 144 + c * 16);
      *(uint4*)(mix + (m0 + t) * 1024 + head * 64 + c * 8) = v;
    }
  }
  __syncthreads();
}

constexpr int SC = 16;
DI void scan_item(const Params& p, int b, int h, int half, char* smem, unsigned* pgen, unsigned kp) {
  const int tid = threadIdx.x;
  const int rp = tid >> 3, cg = tid & 7;
  float* Rl = (float*)smem;
  float* Wl = Rl + SC * 64;
  float* Kl = Wl + SC * 64;
  float* Vl = Kl + SC * 64;
  float* Al = Vl + SC * 64;
  float* Bl = Al + SC * 64;
  float* Yl = Bl + SC * 64;
  float* BON = Yl + SC * 64;
  const u16* proj = (const u16*)(p.ws + OFF_PROJ);
  const float* Wg = (const float*)(p.ws + OFF_BUFA);
  const float* KPg = p.out + (size_t)b * (4096 * 1024) - (size_t)b * T * 512;
  const float* KKg = KPg + (size_t)4096 * 512;
  u16* mix = (u16*)(p.ws + OFF_MIX);
  const int ls = tid >> 4, lc = (tid & 15) * 4;
  const int hc = h * 64 + lc;

  f32x2 St[4];
#pragma unroll
  for (int i = 0; i < 4; ++i) St[i] = (f32x2){0.f, 0.f};

  float* CT = BON + 64;
  __syncthreads();
  if (tid < 64) {
    CT[tid] = p.mu[h * 64 + tid]; CT[64 + tid] = p.mu[1024 + h * 64 + tid]; CT[128 + tid] = p.r_k[h * 64 + tid];
    CT[192 + tid] = p.lnx_w[h * 64 + tid]; CT[256 + tid] = p.lnx_b[h * 64 + tid];
  }
  struct ScanRaw { float4 w, k, kk, a; uint2 rc, vc, rp, vp; };
  float4 pw, pk, pkk, pa, pr, pv;
  float pbon;
  auto prefetch = [&](int c, ScanRaw& R) {
    const int t = c * SC + ls;
    const size_t m = (size_t)b * T + t;
    R.w = *(const float4*)(Wg + m * 512 + hc);
    R.k = *(const float4*)(KPg + m * 512 + hc);
    R.kk = *(const float4*)(KKg + m * 512 + hc);
    R.a = *(const float4*)(aaptr(p.ws, m) + hc);
    R.rc = *(const uint2*)(proj + prow(m) + R_OFF + hc);
    R.vc = *(const uint2*)(proj + prow(m) + V_OFF + hc);
    R.rp = make_uint2(0, 0); R.vp = make_uint2(0, 0);
    if (t > 0) { R.rp = *(const uint2*)(proj + prow(m - 1) + R_OFF + hc); R.vp = *(const uint2*)(proj + prow(m - 1) + V_OFF + hc); }
  };
  auto convert = [&](const ScanRaw& R) {
    const float4 mu_r = *(const float4*)(CT + lc);
    const float4 mu_v = *(const float4*)(CT + 64 + lc);
    const float4 rk = *(const float4*)(CT + 128 + lc);
    pw = R.w; pk = R.k; pkk = R.kk; pa = R.a;
    float c0, p0;
    c0 = lo_bf(R.rc.x); p0 = lo_bf(R.rp.x); pr.x = c0 + (p0 - c0) * mu_r.x;
    c0 = hi_bf(R.rc.x); p0 = hi_bf(R.rp.x); pr.y = c0 + (p0 - c0) * mu_r.y;
    c0 = lo_bf(R.rc.y); p0 = lo_bf(R.rp.y); pr.z = c0 + (p0 - c0) * mu_r.z;
    c0 = hi_bf(R.rc.y); p0 = hi_bf(R.rp.y); pr.w = c0 + (p0 - c0) * mu_r.w;
    c0 = lo_bf(R.vc.x); p0 = lo_bf(R.vp.x); pv.x = c0 + (p0 - c0) * mu_v.x;
    c0 = hi_bf(R.vc.x); p0 = hi_bf(R.vp.x); pv.y = c0 + (p0 - c0) * mu_v.y;
    c0 = lo_bf(R.vc.y); p0 = lo_bf(R.vp.y); pv.z = c0 + (p0 - c0) * mu_v.z;
    c0 = hi_bf(R.vc.y); p0 = hi_bf(R.vp.y); pv.w = c0 + (p0 - c0) * mu_v.w;
    pbon = row16_sum(pr.x * pk.x * rk.x + pr.y * pk.y * rk.y + pr.z * pk.z * rk.z + pr.w * pk.w * rk.w);
  };
  auto override_t0 = [&]() {
    const float* t0 = (const float*)(p.ws + OFF_T0) + (size_t)b * 17 * 64;
    const float4 r0 = *(const float4*)(t0 + h * 64 + lc);
    const float4 k0 = *(const float4*)(t0 + (8 + h) * 64 + lc);
    float av[4] = {p.a0[hc], p.a0[hc + 1], p.a0[hc + 2], p.a0[hc + 3]};
    for (int j = 0; j < 64; ++j) {
      const float xj = t0[16 * 64 + j];
      const float4 a2r = *(const float4*)(p.a2 + (size_t)j * 512 + hc);
      av[0] += xj * a2r.x; av[1] += xj * a2r.y; av[2] += xj * a2r.z; av[3] += xj * a2r.w;
    }
    const float4 kkw = *(const float4*)(p.k_k + hc);
    const float4 kaw = *(const float4*)(p.k_a + hc);
    const float4 rk = *(const float4*)(CT + 128 + lc);
    const float kv[4] = {k0.x, k0.y, k0.z, k0.w}, kkc[4] = {kkw.x, kkw.y, kkw.z, kkw.w}, kac[4] = {kaw.x, kaw.y, kaw.z, kaw.w};
    float kkv[4], kpv[4], aa[4], ssq = 0.f;
#pragma unroll
    for (int e = 0; e < 4; ++e) { aa[e] = sigmoidf_(av[e]); kkv[e] = kv[e] * kkc[e]; ssq += kkv[e] * kkv[e]; kpv[e] = kv[e] * (1.f + (aa[e] - 1.f) * kac[e]); }
    ssq = row16_sum(ssq);
    const float inv = rsqrtf(fmaxf(ssq, 1e-24f));
    pr = r0;
    pk = make_float4(kpv[0], kpv[1], kpv[2], kpv[3]);
    pkk = make_float4(kkv[0] * inv, kkv[1] * inv, kkv[2] * inv, kkv[3] * inv);
    pa = make_float4(aa[0], aa[1], aa[2], aa[3]);
    pbon = row16_sum(pr.x * pk.x * rk.x + pr.y * pk.y * rk.y + pr.z * pk.z * rk.z + pr.w * pk.w * rk.w);
  };
  auto chunk = [&](int c, ScanRaw& R) {
    __syncthreads();
    convert(R);
    if (c == 0 && ls == 0) override_t0();
    *(float4*)(Rl + ls * 64 + lc) = pr;
    *(float4*)(Wl + ls * 64 + lc) = pw;
    *(float4*)(Kl + ls * 64 + lc) = pk;
    *(float4*)(Vl + ls * 64 + lc) = pv;
    *(float4*)(Al + ls * 64 + lc) = make_float4(-pkk.x, -pkk.y, -pkk.z, -pkk.w);
    *(float4*)(Bl + ls * 64 + lc) = make_float4(pkk.x * pa.x, pkk.y * pa.y, pkk.z * pa.z, pkk.w * pa.w);
    if ((tid & 15) == 0) BON[ls] = pbon;
    __syncthreads();
    if (c + 2 == (T / SC) / 4) {
      if (tid == 0) {
        while (__hip_atomic_load(pgen, __ATOMIC_RELAXED, __HIP_MEMORY_SCOPE_AGENT) < kp) __builtin_amdgcn_s_sleep(2);
        __builtin_amdgcn_fence(__ATOMIC_ACQUIRE, "agent");
        asm volatile("s_waitcnt vmcnt(0)" ::: "memory");
      }
      __syncthreads();
    }
    if (c + 2 < T / SC) prefetch(c + 2, R);
#pragma unroll 1
    for (int sg = 0; sg < SC; sg += 4) {
      float yy[4];
#pragma unroll
      for (int s4 = 0; s4 < 4; ++s4) {
        const int s = sg + s4;
        const f32x2* a2 = (const f32x2*)(Al + s * 64 + cg * 8);
        const f32x2* w2 = (const f32x2*)(Wl + s * 64 + cg * 8);
        const f32x2* b2 = (const f32x2*)(Bl + s * 64 + cg * 8);
        const f32x2* k2 = (const f32x2*)(Kl + s * 64 + cg * 8);
        const f32x2* r2 = (const f32x2*)(Rl + s * 64 + cg * 8);
        f32x2 o[20];
#pragma unroll
        for (int i = 0; i < 4; ++i) { o[i] = a2[i]; o[4 + i] = w2[i]; o[8 + i] = b2[i]; o[12 + i] = k2[i]; o[16 + i] = r2[i]; }
        const float vr = Vl[s * 64 + 32 * half + rp];
        f32x2 p0 = St[0] * o[0], p1 = St[1] * o[1];
        p0 = __builtin_elementwise_fma(St[2], o[2], p0); p1 = __builtin_elementwise_fma(St[3], o[3], p1);
        const float sa = oct_sum((p0.x + p0.y) + (p1.x + p1.y));
        const f32x2 sv = {sa, sa}, vv = {vr, vr};
        f32x2 y0 = {0.f, 0.f}, y1 = {0.f, 0.f};
#pragma unroll
        for (int i = 0; i < 4; i += 2) {
          St[i] = __builtin_elementwise_fma(St[i], o[4 + i], __builtin_elementwise_fma(sv, o[8 + i], vv * o[12 + i]));
          St[i + 1] = __builtin_elementwise_fma(St[i + 1], o[5 + i], __builtin_elementwise_fma(sv, o[9 + i], vv * o[13 + i]));
          y0 = __builtin_elementwise_fma(St[i], o[16 + i], y0);
          y1 = __builtin_elementwise_fma(St[i + 1], o[17 + i], y1);
        }
        yy[s4] = oct_sum((y0.x + y0.y) + (y1.x + y1.y));
      }
      if (cg == 0) {
#pragma unroll
        for (int s4 = 0; s4 < 4; ++s4) Yl[(sg + s4) * 32 + rp] = yy[s4];
      }
    }
    __syncthreads();
    {
      const int t = c * SC + ls;
      const size_t m = (size_t)b * T + t;
      const int j2 = (tid & 15) * 2;
      const f32x2 y2 = *(const f32x2*)(Yl + ls * 32 + j2);
      *(unsigned*)(mix + m * 1024 + 512 + h * 64 + 32 * half + j2) = pack2(y2.x, y2.y);
      if (half == 0 && (tid & 15) == 0) ((float*)(p.ws + OFF_BON))[m * 8 + h] = BON[ls];
    }
  };
  ScanRaw RA, RB;
  prefetch(0, RA);
  prefetch(1, RB);
  __builtin_amdgcn_s_setprio(3);
#pragma unroll 1
  for (int c = 0; c < T / SC; c += 2) {
    chunk(c, RA);
    chunk(c + 1, RB);
  }
  __builtin_amdgcn_s_setprio(0);
  __syncthreads();
}


struct GnRaw { uint2 yr, vc, vp, gg; float bon; };
DI GnRaw gn_load(const Params& p, size_t m, int ml, int h, int hc) {
  const u16* proj = (const u16*)(p.ws + OFF_PROJ);
  const u16* mix = (const u16*)(p.ws + OFF_MIX);
  GnRaw r;
  r.yr = *(const uint2*)(mix + m * 1024 + 512 + hc);
  r.vc = *(const uint2*)(proj + prow(m) + V_OFF + hc);
  r.vp = make_uint2(0, 0);
  if (ml > 0) r.vp = *(const uint2*)(proj + prow(m - 1) + V_OFF + hc);
  r.bon = ((const float*)(p.ws + OFF_BON))[m * 8 + h];
  r.gg = *(const uint2*)((const u16*)(p.ws + OFF_G) + m * 512 + hc);
  return r;
}
DI void gn_finish(const Params& p, const GnRaw& r, size_t m, int hc, const float4& mv, const float4& lw, const float4& lb) {
  u16* yp = (u16*)(p.ws + OFF_MIX) + m * 1024 + 512 + hc;
  const float y0 = lo_bf(r.yr.x), y1 = hi_bf(r.yr.x), y2 = lo_bf(r.yr.y), y3 = hi_bf(r.yr.y);
  const float mean = row16_sum(y0 + y1 + y2 + y3) * (1.f / 64.f);
  const float d0 = y0 - mean, d1 = y1 - mean, d2 = y2 - mean, d3 = y3 - mean;
  const float var = row16_sum(d0 * d0 + d1 * d1 + d2 * d2 + d3 * d3) * (1.f / 64.f);
  const float rs = rsqrtf(var + 64e-5f);
  float c0, p0;
  c0 = lo_bf(r.vc.x); p0 = lo_bf(r.vp.x); const float v0 = c0 + (p0 - c0) * mv.x;
  c0 = hi_bf(r.vc.x); p0 = hi_bf(r.vp.x); const float v1 = c0 + (p0 - c0) * mv.y;
  c0 = lo_bf(r.vc.y); p0 = lo_bf(r.vp.y); const float v2 = c0 + (p0 - c0) * mv.z;
  c0 = hi_bf(r.vc.y); p0 = hi_bf(r.vp.y); const float v3 = c0 + (p0 - c0) * mv.w;
  const float o0 = (d0 * rs * lw.x + lb.x + r.bon * v0) * lo_bf(r.gg.x);
  const float o1 = (d1 * rs * lw.y + lb.y + r.bon * v1) * hi_bf(r.gg.x);
  const float o2 = (d2 * rs * lw.z + lb.z + r.bon * v2) * lo_bf(r.gg.y);
  const float o3 = (d3 * rs * lw.w + lb.w + r.bon * v3) * hi_bf(r.gg.y);
  *(uint2*)yp = make_uint2(pack2(o0, o1), pack2(o2, o3));
}
DI void gn_item(const Params& p, int b, int idx) {
  const int tid = threadIdx.x;
  const int lc = (tid & 15) * 4;
  const int qa = idx * 16 + (tid >> 4), qb2 = qa + 16384;
  const int mla = qa >> 3, ha = qa & 7, mlb = qb2 >> 3, hb = qb2 & 7;
  const int hc = ha * 64 + lc;
  const size_t ma = (size_t)b * T + mla, mb = (size_t)b * T + mlb;
  const GnRaw ra = gn_load(p, ma, mla, ha, hc);
  const GnRaw rb = gn_load(p, mb, mlb, hb, hc);
  const float4 mv = *(const float4*)(p.mu + 1024 + hc);
  const float4 lw = *(const float4*)(p.lnx_w + hc);
  const float4 lb = *(const float4*)(p.lnx_b + hc);
  gn_finish(p, ra, ma, hc, mv, lw, lb);
  gn_finish(p, rb, mb, hc, mv, lw, lb);
}

DI void grid_barrier(unsigned* ctr, unsigned target) {
  asm volatile("s_waitcnt vmcnt(0)" ::: "memory");
  __syncthreads();
  if (threadIdx.x == 0) {
    __builtin_amdgcn_s_waitcnt(0);
    __builtin_amdgcn_fence(__ATOMIC_RELEASE, "agent");
    asm volatile("s_waitcnt vmcnt(0)" ::: "memory");
    __hip_atomic_fetch_add(ctr, 1u, __ATOMIC_RELAXED, __HIP_MEMORY_SCOPE_AGENT);
    while (__hip_atomic_load(ctr, __ATOMIC_RELAXED, __HIP_MEMORY_SCOPE_AGENT) < target) __builtin_amdgcn_s_sleep(1);
    __builtin_amdgcn_fence(__ATOMIC_ACQUIRE, "agent");
    asm volatile("s_waitcnt vmcnt(0)" ::: "memory");
  }
  __syncthreads();
}

DI void xcd_barrier(unsigned* ctr, unsigned cnt, unsigned k) {
  asm volatile("s_waitcnt vmcnt(0)" ::: "memory");
  __syncthreads();
  if (threadIdx.x == 0) {
    __builtin_amdgcn_s_waitcnt(0);
    const unsigned old = __hip_atomic_fetch_add(ctr, 1u, __ATOMIC_RELAXED, __HIP_MEMORY_SCOPE_AGENT);
    if (old + 1u == cnt * k) {
      __builtin_amdgcn_fence(__ATOMIC_RELEASE, "agent");
      asm volatile("s_waitcnt vmcnt(0)" ::: "memory");
      __hip_atomic_fetch_add(ctr + 1, 1u, __ATOMIC_RELAXED, __HIP_MEMORY_SCOPE_AGENT);
    } else {
      while (__hip_atomic_load(ctr + 1, __ATOMIC_RELAXED, __HIP_MEMORY_SCOPE_AGENT) < k) __builtin_amdgcn_s_sleep(1);
    }
    __builtin_amdgcn_fence(__ATOMIC_ACQUIRE, "agent");
    asm volatile("s_waitcnt vmcnt(0)" ::: "memory");
  }
  __syncthreads();
}

DI void t0_item(const Params& p, int item, char* smem) {
  const int b = item / 17, grp = item - b * 17;
  const int tid = threadIdx.x;
  float* xs = (float*)smem;
  float* red = xs + 1024;
  __syncthreads();
  const float* xr = p.x + (size_t)b * T * 1024;
  float ss = 0.f;
  for (int i = tid; i < 1024; i += 256) { const float v = xr[i]; ss += v * v; }
  ss = wave_sum(ss);
  __syncthreads();
  if ((tid & 63) == 0) red[tid >> 6] = ss;
  __syncthreads();
  const float sc = rsqrtf((red[0] + red[1] + red[2] + red[3]) * (1.f / 1024.f) + 1e-6f);
  for (int i = tid; i < 1024; i += 256) xs[i] = xr[i] * sc * p.ln_mix_g[i];
  __syncthreads();
  const int c = tid & 63, kp = tid >> 6;
  const int rc = grp < 8 ? grp * 64 + c : (grp < 16 ? 512 + (grp - 8) * 64 + c : 1600 + c);
  const float* wc = p.w_in + 1304 + rc;
  float a = 0.f;
#pragma unroll 8
  for (int k = kp * 256; k < kp * 256 + 256; ++k) a += xs[k] * wc[(size_t)k * 3096];
  __syncthreads();
  red[tid] = a;
  __syncthreads();
  if (tid < 64) {
    const float v = red[tid] + red[tid + 64] + red[tid + 128] + red[tid + 192];
    ((float*)(p.ws + OFF_T0))[(size_t)(b * 17 + grp) * 64 + tid] = v * (1.f - p.mu[rc]);
  }
  __syncthreads();
}


struct XcdInfo { int pi, npop, rank, cnt; };
DI XcdInfo xcd_setup(unsigned* ctrbase, char* smem) {
  int* sx = (int*)(smem + 73728 - 64);
  if (threadIdx.x == 0) {
    const unsigned xcc = (unsigned)__builtin_amdgcn_s_getreg((3 << 11) | 20) & 0xFu;
    unsigned* census = ctrbase + 16;
    const unsigned rank = __hip_atomic_fetch_add(&census[xcc], 1u, __ATOMIC_RELAXED, __HIP_MEMORY_SCOPE_AGENT);
    for (;;) {
      unsigned sum = 0, npop = 0, pi = 0, mine = 0;
      for (unsigned j = 0; j < 16; ++j) {
        const unsigned v = __hip_atomic_load(&census[j], __ATOMIC_RELAXED, __HIP_MEMORY_SCOPE_AGENT);
        sum += v; npop += (v > 0u) ? 1u : 0u; pi += (v > 0u && j < xcc) ? 1u : 0u; mine = (j == xcc) ? v : mine;
      }
      if (sum == gridDim.x) { sx[0] = (int)pi; sx[1] = (int)npop; sx[2] = (int)rank; sx[3] = (int)mine; break; }
      __builtin_amdgcn_s_sleep(2);
    }
  }
  __syncthreads();
  XcdInfo X;
  X.pi = sx[0]; X.npop = sx[1]; X.rank = sx[2]; X.cnt = sx[3];
  __syncthreads();
  return X;
}
#define FOR_BATCH(b) for (int b = X.pi; b < 8; b += X.npop)
#define FOR_ITEMS(i, n) for (int i = X.rank; i < (n); i += X.cnt)

#ifndef PH
#define PH 0xFFF
#endif
#ifndef USE_CG
#define USE_CG 0
#endif
#ifndef DBL
#define DBL 0
#endif
#define PM(bit) (((DBL) & (bit)) ? 2 : 1)
__global__ void __launch_bounds__(256, 2) fwd_megakernel(Params p) {
  __shared__ __attribute__((aligned(16))) char smem[73728];
  cg::grid_group grid = cg::this_grid();
  const int nb = gridDim.x, bid = blockIdx.x, tid = threadIdx.x;
  unsigned* ctrs = (unsigned*)(p.ws + OFF_CTR);
  unsigned* bar = ctrs + 32;
  const XcdInfo X = xcd_setup(ctrs, smem);
  unsigned* xbar = ctrs + 64 + 32 * X.pi;

  {
    constexpr int N0 = 800, N1 = N0 + 256, N2 = N1 + 1024, N3 = N2 + 1024, N4 = N3 + 64, N5 = N4 + 64, N6 = N5 + 8, N7 = N6 + 8, N8 = N7 + 16;
    constexpr int NTOT = N8 + 65;
    for (int it0 = bid; it0 < NTOT * PM(8); it0 += nb) {
      const int it = it0 % NTOT;
      if (it < N0) { int i = it; transpose_tile(p.w_in, 3096, (u16*)(p.ws + OFF_WTIN), 1024, (i % 16) * 64, (i / 16) * 64, true, smem); }
      else if (it < N1) { int i = it - N0; transpose_tile(p.w_out, 1024, (u16*)(p.ws + OFF_WTOUT), 1024, (i % 16) * 64, (i / 16) * 64, false, smem); }
      else if (it < N2) { int i = it - N1; transpose_tile(p.w_ff1, 4096, (u16*)(p.ws + OFF_WTFF1), 1024, (i % 16) * 64, (i / 16) * 64, false, smem); }
      else if (it < N3) { int i = it - N2; transpose_tile(p.w_ff2, 1024, (u16*)(p.ws + OFF_WTFF2), 4096, (i % 64) * 64, (i / 64) * 64, false, smem); }
      else if (it < N4) { int i = it - N3; transpose_tile(p.ck_w1, 128, (u16*)(p.ws + OFF_CW1T), 2048, (i % 32) * 64, (i / 32) * 64, false, smem); }
      else if (it < N5) { int i = it - N4; transpose_tile(p.cv_w1, 128, (u16*)(p.ws + OFF_CW1T) + 128 * 2048, 2048, (i % 32) * 64, (i / 32) * 64, false, smem); }
      else if (it < N6) { int i = it - N5; transpose_tile(p.w2, 512, (u16*)(p.ws + OFF_W2T), 64, 0, i * 64, false, smem); }
      else if (it < N7) { int i = it - N6; transpose_tile(p.a2, 512, (u16*)(p.ws + OFF_A2T), 64, 0, i * 64, false, smem); }
      else if (it < N8) { int i = it - N7; transpose_tile(p.g2, 512, (u16*)(p.ws + OFF_G2T), 128, (i % 2) * 64, (i / 2) * 64, false, smem); }
      else if (it < N8 + 64) {
        const int idx = it - N8, kv = idx & 1, kc = idx >> 1;
        const float* pos = kv ? p.cv_pos : p.ck_pos;
        const float* w1 = kv ? p.cv_w1 : p.ck_w1;
        const int j = tid & 127, hh = tid >> 7;
        float a = 0.f;
#pragma unroll 8
        for (int k = kc * 64 + hh * 32; k < kc * 64 + hh * 32 + 32; ++k) a += pos[k] * w1[(size_t)k * 128 + j];
        float* s = (float*)smem;
        __syncthreads();
        s[tid] = a;
        __syncthreads();
        if (tid < 128) ((float*)(p.ws + OFF_PBP))[(kv * 32 + kc) * 128 + tid] = s[tid] + s[tid + 128];
        __syncthreads();
      } else {
        u16* kcn = (u16*)(p.ws + OFF_KCN);
        u16* vct = (u16*)(p.ws + OFF_VCT);
        for (int i = tid; i < 16 * 64; i += 256) {
          const int bh = i >> 6, d = i & 63;
          kcn[((size_t)bh * 256 + 255) * 64 + d] = 0;
          vct[((size_t)bh * 64 + d) * 256 + 255] = 0;
        }
      }
    }
    FOR_BATCH(b) FOR_ITEMS(i, 1024 * PM(8)) rmsnorm_rows(p.x, p.ln_mix_g, (u16*)(p.ws + OFF_BUFA), b * 1024 + (i & 1023));
  }
  asm volatile("s_waitcnt vmcnt(0)" ::: "memory");
  grid.sync();
  FOR_BATCH(b) FOR_ITEMS(i0, 400 * PM(32)) {
    const int i = i0 % 400;
    const int tng = i / 80, rem = i - tng * 80;
    gemm_tile<G_INPROJ, true>(p, b * 16 + rem / 5, tng * 5 + rem % 5, 0, smem);
  }
  xcd_barrier(xbar, (unsigned)X.cnt, 1u);
  {
    const int NS = X.cnt >= 32 ? 16 : (X.cnt >> 1);
    const int PS = X.cnt - NS, pr = X.rank - NS;
    unsigned* pbar = xbar + 2;
    unsigned kp = 0;
#pragma unroll 1
    for (int stage = 0; stage < 2; ++stage) {
      FOR_BATCH(b) {
        const bool mine = (stage == 0) || (pr >= 0);
        const int start = stage == 0 ? X.rank : pr, stride = stage == 0 ? X.cnt : PS, lo = stage * 32, hi = stage == 0 ? 32 : 128;
        if (mine) {
          for (int i = lo + start; i < hi; i += stride) gemm_tile<G_RWW>(p, b * 32 + (i >> 2), i & 3, 0, smem);
          for (int i = lo + start; i < hi; i += stride) gemm_tile<G_RWA>(p, b * 32 + (i >> 2), i & 3, 0, smem);
        }
        if (stage == 0) {
          for (int i = (X.rank + (X.cnt >> 1)) % X.cnt; i < 17; i += X.cnt) t0_item(p, b * 17 + i, smem);
        } else {
          ++kp;
          if (pr < 0) {
            for (int i = X.rank; i < 16; i += NS) scan_item(p, b, i >> 1, i & 1, smem, pbar + 1, kp);
            if (tid == 0) {
              while (__hip_atomic_load(pbar + 1, __ATOMIC_RELAXED, __HIP_MEMORY_SCOPE_AGENT) < kp) __builtin_amdgcn_s_sleep(2);
              __builtin_amdgcn_fence(__ATOMIC_ACQUIRE, "agent");
              asm volatile("s_waitcnt vmcnt(0)" ::: "memory");
            }
            __syncthreads();
          } else {
            const bool cpool = PS > 8;
            const int st = cpool ? PS - 8 : PS, me = cpool ? pr - 8 : pr;
            for (int i = pr; i < 8; i += PS) gemm_tile<G_CMP>(p, b * 4 + (i >> 1), 0, i & 1, smem);
            if (me >= 0) {
              for (int i = me; i < 256; i += st) vtrans_item(p, ((i >> 7) << 10) | (b << 7) | (i & 127), smem);
            }
            asm volatile("s_waitcnt vmcnt(0)" ::: "memory");
            __syncthreads();
            if (tid == 0) {
              __builtin_amdgcn_s_waitcnt(0);
              const unsigned old = __hip_atomic_fetch_add(pbar, 1u, __ATOMIC_RELAXED, __HIP_MEMORY_SCOPE_AGENT);
              if (old + 1u == (unsigned)PS * kp) __hip_atomic_fetch_add(pbar + 1, 1u, __ATOMIC_RELAXED, __HIP_MEMORY_SCOPE_AGENT);
              else while (__hip_atomic_load(pbar + 1, __ATOMIC_RELAXED, __HIP_MEMORY_SCOPE_AGENT) < kp) __builtin_amdgcn_s_sleep(1);
              __builtin_amdgcn_fence(__ATOMIC_ACQUIRE, "agent");
              asm volatile("s_waitcnt vmcnt(0)" ::: "memory");
            }
            __syncthreads();
          }
          int* sitem = (int*)(smem + 73728 - 16);
          while (true) {
            __syncthreads();
            if (tid == 0) *sitem = (int)atomicAdd(&ctrs[b], 1u);
            __syncthreads();
            const int item = *sitem;
            if (item >= 256 + 128) break;
            if (item < 256) attn_item(p, b, item, smem);
            else { const int i = item - 256; gemm_tile<G_RWG>(p, b * 32 + (i >> 2), i & 3, 0, smem); }
          }
        }
      }
      if (stage == 0) xcd_barrier(xbar, (unsigned)X.cnt, 2u);
    }
  }
  xcd_barrier(xbar, (unsigned)X.cnt, 3u);
  FOR_BATCH(b) FOR_ITEMS(i, 1024) gn_item(p, b, i);
  xcd_barrier(xbar, (unsigned)X.cnt, 4u);
  FOR_BATCH(b) FOR_ITEMS(i0, 128 * PM(64)) { const int i = i0 & 127; gemm_tile<G_OUT, true>(p, b * 16 + (i >> 3), i & 7, 0, smem); }
  xcd_barrier(xbar, (unsigned)X.cnt, 5u);
  FOR_BATCH(b) FOR_ITEMS(i, 1024 * PM(128)) rmsnorm_rows(p.out, p.ln_ffn_g, (u16*)(p.ws + OFF_BUFA), b * 1024 + (i & 1023));
  xcd_barrier(xbar, (unsigned)X.cnt, 6u);
  for (int rep = 0; rep < ((DBL & 1) ? 2 : 1); ++rep)
  FOR_BATCH(b) FOR_ITEMS(i, 512) {
    const int tnh = i >> 7, tm = (i >> 3) & 15, tnl = i & 7;
    gemm_tile<G_FF1, true>(p, b * 16 + tm, tnh * 8 + tnl, 0, smem);
  }
  xcd_barrier(xbar, (unsigned)X.cnt, 7u);
  FOR_BATCH(b) FOR_ITEMS(i, 128) gemm_tile<G_FF2, true>(p, b * 16 + (i >> 3), i & 7, 0, smem);
}

extern "C" void kernel_launch(void* const* d_in, const int* in_sizes, int n_in, void* d_out, int out_size, void* d_ws, size_t ws_size,
                              hipStream_t stream) {
  static int grid_blocks = 0;
  if (!grid_blocks) {
    int dev = 0, cus = 0, per_cu = 0;
    hipGetDevice(&dev);
    hipDeviceGetAttribute(&cus, hipDeviceAttributeMultiprocessorCount, dev);
    hipOccupancyMaxActiveBlocksPerMultiprocessor(&per_cu, fwd_megakernel, 256, 0);
    if (per_cu > 2) per_cu = 2;
    if (per_cu < 1) per_cu = 1;
    grid_blocks = cus * per_cu;
  }
  Params p{};
  const float** f = (const float**)&p;
  for (int i = 0; i < 29; ++i) f[i] = (const float*)d_in[i];
  p.out = (float*)d_out;
  p.ws = (char*)d_ws;
  hipMemsetAsync((char*)d_ws + OFF_CTR, 0, 4096, stream);
  void* args[] = {&p};
  hipError_t e = hipLaunchCooperativeKernel((void*)fwd_megakernel, dim3(grid_blocks), dim3(256), args, 0, stream);
  if (e != hipSuccess) fprintf(stderr, "cooperative launch failed: %s (grid %d)\n", hipGetErrorString(e), grid_blocks);
}
```
